# Optimizing an MI355X kernel written in HIP

```python
import math
import jax
import jax.numpy as jnp
from jax import lax
import numpy as np

D_MODEL = 1024
BATCH = 8
SEQ = 4096
DEPTH = 4
DEC_BATCH = 16
DEC_SEQ = 32
PAST_LEN = 4096

CHUNK = 64
Q_BLOCK = 128
D_SSM = 2 * D_MODEL
SSM_HEAD_DIM = 64
N_SSM_HEADS = D_SSM // SSM_HEAD_DIM
SSM_GROUPS = 4
D_STATE = 128
CONV_W = 4
CONV_DIM = D_SSM + 2 * SSM_GROUPS * D_STATE
N_MLA_HEADS = 16
D_NOPE = 64
D_ROPE = 32
D_V = 64
Q_LORA = D_MODEL // 2
KV_LORA = D_MODEL // 4
D_MLA = N_MLA_HEADS * D_V
MLA_SCALE = (D_NOPE + D_ROPE) ** -0.5
ROPE_THETA = 10000.0
N_MEM = 256
MEM_HEADS = 4
MEM_HEAD_DIM = D_MODEL // MEM_HEADS
D_MEM = MEM_HEADS * MEM_HEAD_DIM
N_BRANCH = 3
SPLITS = (D_SSM, CONV_DIM, N_SSM_HEADS, Q_LORA, KV_LORA, D_ROPE, D_MLA, D_MEM, N_BRANCH * D_MODEL)
D_IN = sum(SPLITS)
SPLIT_IDX = tuple(int(v) for v in np.cumsum(SPLITS)[:-1])
ALPHA = (2 * DEPTH) ** 0.25
BETA = (8 * DEPTH) ** -0.25
EPS = 1e-5
NEG_INF = -1e30

kernel_name = 'ssd_mla_memory_streaming_encoder'


def layer_norm(x, g, b):
    xf = x.astype(jnp.float32)
    mu = jnp.mean(xf, -1, keepdims=True)
    var = jnp.mean(jnp.square(xf - mu), -1, keepdims=True)
    return ((xf - mu) * lax.rsqrt(var + EPS) * g.astype(jnp.float32) + b.astype(jnp.float32)).astype(x.dtype)


def rms_norm(x, w):
    xf = x.astype(jnp.float32)
    return (xf * lax.rsqrt(jnp.mean(jnp.square(xf), -1, keepdims=True) + EPS) * w.astype(jnp.float32)).astype(x.dtype)


def gated_group_rmsnorm(y, z, w):
    g = y.astype(jnp.float32) * jax.nn.silu(z.astype(jnp.float32))
    gs = g.reshape(g.shape[:-1] + (SSM_GROUPS, D_SSM // SSM_GROUPS))
    gs = gs * lax.rsqrt(jnp.mean(jnp.square(gs), -1, keepdims=True) + EPS)
    return gs.reshape(g.shape) * w.astype(jnp.float32)


def rope(x, pos):
    half = x.shape[-1] // 2
    inv = ROPE_THETA ** (-jnp.arange(half, dtype=jnp.float32) / half)
    ang = pos.astype(jnp.float32)[:, None] * inv[None, :]
    cos = jnp.cos(ang)[:, None, :]
    sin = jnp.sin(ang)[:, None, :]
    xf = x.astype(jnp.float32)
    x1, x2 = xf[..., :half], xf[..., half:]
    return jnp.concatenate([x1 * cos - x2 * sin, x2 * cos + x1 * sin], -1).astype(x.dtype)


def causal_conv(xbc, prev, w, bias):
    l = xbc.shape[1]
    xp = jnp.concatenate([prev.astype(xbc.dtype), xbc], axis=1)
    y = bias
    for k in range(CONV_W):
        y = y + xp[:, k:k + l] * w[k]
    return jax.nn.silu(y), xp[:, xp.shape[1] - (CONV_W - 1):]


def segsum(x):
    t = x.shape[-1]
    xc = jnp.cumsum(x, -1)
    s = xc[..., :, None] - xc[..., None, :]
    return jnp.where(jnp.tril(jnp.ones((t, t), dtype=bool)), s, -jnp.inf)


def ssd_scan(xh, dt, a, bm, cm, h0):
    b, l = xh.shape[:2]
    t = min(CHUNK, l)
    nc = l // t
    r = N_SSM_HEADS // SSM_GROUPS
    xd = (xh.astype(jnp.float32) * dt[..., None]).reshape(b, nc, t, SSM_GROUPS, r, SSM_HEAD_DIM)
    da = (dt * a).reshape(b, nc, t, SSM_GROUPS, r).transpose(0, 3, 4, 1, 2)
    bc = bm.astype(jnp.float32).reshape(b, nc, t, SSM_GROUPS, D_STATE)
    cc = cm.astype(jnp.float32).reshape(b, nc, t, SSM_GROUPS, D_STATE)
    a_cs = jnp.cumsum(da, -1)
    lmat = jnp.exp(segsum(da))
    y_diag = jnp.einsum('bclgn,bcsgn,bgrcls,bcsgrp->bclgrp', cc, bc, lmat, xd)
    decay_states = jnp.exp(a_cs[..., -1:] - a_cs)
    states = jnp.einsum('bclgn,bgrcl,bclgrp->bcgrpn', bc, decay_states, xd)
    h0 = h0.astype(jnp.float32).reshape(b, SSM_GROUPS, r, SSM_HEAD_DIM, D_STATE)
    states = jnp.concatenate([h0[:, None], states], axis=1)
    a_last = jnp.pad(a_cs[..., -1], ((0, 0), (0, 0), (0, 0), (1, 0)))
    chunk_decay = jnp.exp(segsum(a_last))
    new_states = jnp.einsum('bgrzc,bcgrpn->bzgrpn', chunk_decay, states)
    states, final = new_states[:, :-1], new_states[:, -1]
    y_off = jnp.einsum('bclgn,bcgrpn,bgrcl->bclgrp', cc, states, jnp.exp(a_cs))
    y = (y_diag + y_off).reshape(b, l, N_SSM_HEADS, SSM_HEAD_DIM)
    return y, final.reshape(b, N_SSM_HEADS, SSM_HEAD_DIM, D_STATE)


def mla_block_attend(q_nope, q_rope, k_nope, k_rope, v, q_pos, k_pos):
    s = (jnp.einsum('bqhd,bkhd->bhqk', q_nope, k_nope)
         + jnp.einsum('bqhr,bkr->bhqk', q_rope, k_rope)).astype(jnp.float32) * MLA_SCALE
    visible = k_pos[None, :] < ((q_pos // CHUNK + 1) * CHUNK)[:, None]
    s = jnp.where(visible[None, None], s, NEG_INF)
    p = jax.nn.softmax(s, axis=-1).astype(v.dtype)
    return jnp.einsum('bhqk,bkhd->bqhd', p, v)


def mla_attention(q_nope, q_rope, k_nope, k_rope, v, q_pos, k_pos):
    b, l = q_nope.shape[:2]
    if l % Q_BLOCK != 0:
        return mla_block_attend(q_nope, q_rope, k_nope, k_rope, v, q_pos, k_pos)
    nb = l // Q_BLOCK
    qn = q_nope.reshape(b, nb, Q_BLOCK, N_MLA_HEADS, D_NOPE).swapaxes(0, 1)
    qr = q_rope.reshape(b, nb, Q_BLOCK, N_MLA_HEADS, D_ROPE).swapaxes(0, 1)
    qp = q_pos.reshape(nb, Q_BLOCK)
    out = lax.map(lambda a: mla_block_attend(a[0], a[1], k_nope, k_rope, v, a[2], k_pos), (qn, qr, qp))
    return out.swapaxes(0, 1).reshape(b, l, N_MLA_HEADS, D_V)


def memory_attention(q, mk, mv):
    s = jnp.einsum('blhd,bmhd->bhlm', q, mk).astype(jnp.float32) * (MEM_HEAD_DIM ** -0.5)
    p = jax.nn.softmax(s, axis=-1).astype(mv.dtype)
    return jnp.einsum('bhlm,bmhd->blhd', p, mv)


def trunk_layer(x, pos, conv_prev, ssm_prev, ckv_prev, krope_prev, mem_k, mem_v,
                w_in, conv_w, conv_b, dt_bias, a_log, d_skip, ssm_norm_w, w_o_ssm,
                q_a_norm_w, w_q_b, kv_norm_w, w_uk, w_uv, w_o_mla, w_o_mem, w_out, ln_g, ln_b):
    b, l, _ = x.shape
    proj = jnp.einsum('bld,de->ble', x, w_in)
    z, xbc, dt_raw, q_a, kv_a, k_r, g_mla, q_mem, gates = jnp.split(proj, SPLIT_IDX, axis=-1)

    xbc, conv_new = causal_conv(xbc, conv_prev, conv_w, conv_b)
    xs, bm, cm = jnp.split(xbc, [D_SSM, D_SSM + SSM_GROUPS * D_STATE], axis=-1)
    xs = xs.reshape(b, l, N_SSM_HEADS, SSM_HEAD_DIM)
    dt = jax.nn.softplus(dt_raw.astype(jnp.float32) + dt_bias.astype(jnp.float32))
    a = -jnp.exp(a_log.astype(jnp.float32))
    y, ssm_new = ssd_scan(xs, dt, a, bm.reshape(b, l, SSM_GROUPS, D_STATE),
                          cm.reshape(b, l, SSM_GROUPS, D_STATE), ssm_prev)
    y = y + d_skip.astype(jnp.float32)[:, None] * xs.astype(jnp.float32)
    y = gated_group_rmsnorm(y.reshape(b, l, D_SSM), z, ssm_norm_w).astype(x.dtype)
    y_ssm = jnp.einsum('ble,ed->bld', y, w_o_ssm)

    q = jnp.einsum('blr,re->ble', rms_norm(q_a, q_a_norm_w), w_q_b).reshape(b, l, N_MLA_HEADS, D_NOPE + D_ROPE)
    q_nope = q[..., :D_NOPE]
    q_rope = rope(q[..., D_NOPE:], pos)
    ckv = rms_norm(kv_a, kv_norm_w)
    krope = rope(k_r[:, :, None, :], pos)[:, :, 0]
    if ckv_prev is None:
        ckv_all, krope_all, k_pos = ckv, krope, pos
    else:
        ckv_all = jnp.concatenate([ckv_prev.astype(ckv.dtype), ckv], axis=1)
        krope_all = jnp.concatenate([krope_prev.astype(krope.dtype), krope], axis=1)
        k_pos = jnp.arange(ckv_all.shape[1], dtype=jnp.int32)
    k_nope = jnp.einsum('bkc,chd->bkhd', ckv_all, w_uk)
    v = jnp.einsum('bkc,chd->bkhd', ckv_all, w_uv)
    o = mla_attention(q_nope, q_rope, k_nope, krope_all, v, pos, k_pos).reshape(b, l, D_MLA)
    y_mla = jnp.einsum('ble,ed->bld', o * jax.nn.silu(g_mla), w_o_mla)

    om = memory_attention(q_mem.reshape(b, l, MEM_HEADS, MEM_HEAD_DIM), mem_k.astype(x.dtype), mem_v.astype(x.dtype))
    y_mem = jnp.einsum('ble,ed->bld', om.reshape(b, l, D_MEM), w_o_mem)

    g = jax.nn.sigmoid(gates).reshape(b, l, N_BRANCH, D_MODEL)
    h = g[:, :, 0] * y_ssm + g[:, :, 1] * y_mla + g[:, :, 2] * y_mem
    out = jnp.einsum('bld,de->ble', h, w_out)
    x_new = layer_norm(ALPHA * x + out, ln_g, ln_b)
    return x_new, conv_new, ssm_new, ckv, krope


def setup_inputs(seed: int = 0) -> dict:
    key = jax.random.key(seed)
    ks = jax.random.split(key, 32)
    f32 = jnp.float32

    def nrm(k, shape, scale):
        return jax.random.normal(k, shape, f32) * scale

    dt0 = jnp.exp(jax.random.uniform(ks[14], (DEPTH, N_SSM_HEADS), f32, minval=math.log(1e-3), maxval=math.log(1e-1)))
    return {
        'x_prompt': nrm(ks[0], (BATCH, SEQ, D_MODEL), 1.0),
        'x_sample': nrm(ks[1], (DEC_BATCH, DEC_SEQ, D_MODEL), 1.0),
        'mem_prompt': nrm(ks[2], (BATCH, N_MEM, D_MODEL), 1.0),
        'state_ssm': nrm(ks[3], (DEPTH, DEC_BATCH, N_SSM_HEADS, SSM_HEAD_DIM, D_STATE), 0.1),
        'state_conv': nrm(ks[4], (DEPTH, DEC_BATCH, CONV_W - 1, CONV_DIM), 1.0),
        'cache_ckv': nrm(ks[5], (DEPTH, DEC_BATCH, PAST_LEN, KV_LORA), 1.0),
        'cache_krope': nrm(ks[6], (DEPTH, DEC_BATCH, PAST_LEN, D_ROPE), 1.0),
        'cache_mem_k': nrm(ks[7], (DEPTH, DEC_BATCH, N_MEM, MEM_HEADS, MEM_HEAD_DIM), 1.0),
        'cache_mem_v': nrm(ks[8], (DEPTH, DEC_BATCH, N_MEM, MEM_HEADS, MEM_HEAD_DIM), 1.0),
        'ln_in_g': 1.0 + nrm(ks[9], (D_MODEL,), 0.02),
        'ln_in_b': nrm(ks[10], (D_MODEL,), 0.02),
        'w_in': nrm(ks[11], (DEPTH, D_MODEL, D_IN), D_MODEL ** -0.5),
        'conv_w': nrm(ks[12], (DEPTH, CONV_W, CONV_DIM), CONV_W ** -0.5),
        'conv_b': nrm(ks[13], (DEPTH, CONV_DIM), 0.02),
        'dt_bias': dt0 + jnp.log(-jnp.expm1(-dt0)),
        'a_log': jnp.log(jax.random.uniform(ks[15], (DEPTH, N_SSM_HEADS), f32, minval=1.0, maxval=16.0)),
        'd_skip': 1.0 + nrm(ks[16], (DEPTH, N_SSM_HEADS), 0.1),
        'ssm_norm_w': 1.0 + nrm(ks[17], (DEPTH, D_SSM), 0.02),
        'w_o_ssm': nrm(ks[18], (DEPTH, D_SSM, D_MODEL), BETA * D_SSM ** -0.5),
        'q_a_norm_w': 1.0 + nrm(ks[19], (DEPTH, Q_LORA), 0.02),
        'w_q_b': nrm(ks[20], (DEPTH, Q_LORA, N_MLA_HEADS * (D_NOPE + D_ROPE)), Q_LORA ** -0.5),
        'kv_norm_w': 1.0 + nrm(ks[21], (DEPTH, KV_LORA), 0.02),
        'w_uk': nrm(ks[22], (DEPTH, KV_LORA, N_MLA_HEADS, D_NOPE), KV_LORA ** -0.5),
        'w_uv': nrm(ks[23], (DEPTH, KV_LORA, N_MLA_HEADS, D_V), KV_LORA ** -0.5),
        'w_o_mla': nrm(ks[24], (DEPTH, D_MLA, D_MODEL), BETA * D_MLA ** -0.5),
        'w_mem_k': nrm(ks[25], (DEPTH, D_MODEL, D_MEM), D_MODEL ** -0.5),
        'w_mem_v': nrm(ks[26], (DEPTH, D_MODEL, D_MEM), D_MODEL ** -0.5),
        'w_o_mem': nrm(ks[27], (DEPTH, D_MEM, D_MODEL), BETA * D_MEM ** -0.5),
        'w_out': nrm(ks[28], (DEPTH, D_MODEL, D_MODEL), BETA * D_MODEL ** -0.5),
        'ln_g': 1.0 + nrm(ks[29], (DEPTH, D_MODEL), 0.02),
        'ln_b': nrm(ks[30], (DEPTH, D_MODEL), 0.02),
    }


def reference(x_prompt, x_sample, mem_prompt, state_ssm, state_conv, cache_ckv, cache_krope,
              cache_mem_k, cache_mem_v, ln_in_g, ln_in_b, w_in, conv_w, conv_b, dt_bias, a_log,
              d_skip, ssm_norm_w, w_o_ssm, q_a_norm_w, w_q_b, kv_norm_w, w_uk, w_uv, w_o_mla,
              w_mem_k, w_mem_v, w_o_mem, w_out, ln_g, ln_b):
    b_p, l_p = x_prompt.shape[:2]
    l_s = x_sample.shape[1]
    past = cache_ckv.shape[2]
    pos_p = jnp.arange(l_p, dtype=jnp.int32)
    pos_s = past + jnp.arange(l_s, dtype=jnp.int32)
    xp = layer_norm(x_prompt, ln_in_g, ln_in_b)
    xs = layer_norm(x_sample, ln_in_g, ln_in_b)
    conv0 = jnp.zeros((b_p, CONV_W - 1, CONV_DIM), x_prompt.dtype)
    ssm0 = jnp.zeros((b_p, N_SSM_HEADS, SSM_HEAD_DIM, D_STATE), jnp.float32)
    p_ssm, p_conv, p_ckv, p_krope, p_mk, p_mv = [], [], [], [], [], []
    s_ssm, s_conv, s_ckv, s_krope = [], [], [], []
    for i in range(DEPTH):
        lw = (w_in[i], conv_w[i], conv_b[i], dt_bias[i], a_log[i], d_skip[i], ssm_norm_w[i], w_o_ssm[i],
              q_a_norm_w[i], w_q_b[i], kv_norm_w[i], w_uk[i], w_uv[i], w_o_mla[i], w_o_mem[i], w_out[i],
              ln_g[i], ln_b[i])
        mk = jnp.einsum('bmd,de->bme', mem_prompt, w_mem_k[i]).reshape(b_p, N_MEM, MEM_HEADS, MEM_HEAD_DIM)
        mv = jnp.einsum('bmd,de->bme', mem_prompt, w_mem_v[i]).reshape(b_p, N_MEM, MEM_HEADS, MEM_HEAD_DIM)
        xp, c_p, st_p, ckv_p, kr_p = trunk_layer(xp, pos_p, conv0, ssm0, None, None, mk, mv, *lw)
        xs, c_s, st_s, ckv_s, kr_s = trunk_layer(xs, pos_s, state_conv[i], state_ssm[i], cache_ckv[i],
                                                 cache_krope[i], cache_mem_k[i], cache_mem_v[i], *lw)
        p_ssm.append(st_p)
        p_conv.append(c_p)
        p_ckv.append(ckv_p)
        p_krope.append(kr_p)
        p_mk.append(mk)
        p_mv.append(mv)
        s_ssm.append(st_s)
        s_conv.append(c_s)
        s_ckv.append(ckv_s)
        s_krope.append(kr_s)
    return (xp, xs, jnp.stack(p_ssm), jnp.stack(p_conv), jnp.stack(p_ckv), jnp.stack(p_krope),
            jnp.stack(p_mk), jnp.stack(p_mv), jnp.stack(s_ssm), jnp.stack(s_conv), jnp.stack(s_ckv),
            jnp.stack(s_krope))
```

```cpp
#include <hip/hip_runtime.h>
#include <hip/hip_cooperative_groups.h>
#include <cstdio>
#include <cstdint>
namespace cg = cooperative_groups;

#define LAS __attribute__((address_space(3)))
typedef unsigned short bf16_t;
typedef short bf16x8 __attribute__((ext_vector_type(8)));
typedef float f32x4 __attribute__((ext_vector_type(4)));
typedef float f32x16 __attribute__((ext_vector_type(16)));
typedef unsigned u32x4 __attribute__((ext_vector_type(4)));
typedef unsigned u32x2 __attribute__((ext_vector_type(2)));

constexpr int DM = 1024, MP = 32768, MS = 512, MT = MP + MS, SEQ = 4096, NB = 8, NSB = 16, DSEQ = 32, PAST = 4096, DEPTH = 4;
constexpr int NPJ = 11264;
constexpr int C_Z = 0, C_XBC = 2048, C_QA = 5120, C_KVA = 5632, C_GM = 5888, C_QM = 6912, C_GT = 7936, C_DT = 11008, C_KR = 11040;
constexpr int C_Q = 2048, C_KN = 3584, C_H = 2048;
constexpr float LN_EPS = 1e-5f;
constexpr float ALPHA = 1.681792830507429f;
constexpr float LOG2E = 1.4426950408889634f;
constexpr float MLA_SC = 0.10206207261596575f * LOG2E;
constexpr float MEM_SC = 0.0625f * LOG2E;
constexpr long O_Y = 0;
constexpr long O_PSSM = (long)MT * DM;
constexpr long O_PCONV = O_PSSM + 4L * 8 * 32 * 64 * 128;
constexpr long O_PCKV = O_PCONV + 4L * 8 * 3 * 3072;
constexpr long O_PKR = O_PCKV + 4L * 8 * 4096 * 256;
constexpr long O_PMK = O_PKR + 4L * 8 * 4096 * 32;
constexpr long O_PMV = O_PMK + 4L * 8 * 256 * 1024;
constexpr long O_SSSM = O_PMV + 4L * 8 * 256 * 1024;
constexpr long O_SCONV = O_SSSM + 4L * 16 * 32 * 64 * 128;
constexpr long O_SCKV = O_SCONV + 4L * 16 * 3 * 3072;
constexpr long O_SKR = O_SCKV + 4L * 16 * 32 * 256;
constexpr size_t WS_PROJ = 0;
constexpr size_t WS_XB = WS_PROJ + (size_t)MT * NPJ * 2;
constexpr size_t WS_W = WS_XB + (size_t)MT * DM * 2;
constexpr size_t W_IN = 0, W_OSSM = W_IN + (size_t)NPJ * 1024, W_QB = W_OSSM + 1024 * 2048, W_UK = W_QB + 1536 * 512, W_UV = W_UK + 1024 * 256,
                 W_OMLA = W_UV + 1024 * 256, W_OMEM = W_OMLA + 1024 * 1024, W_OUT = W_OMEM + 1024 * 1024, W_MK = W_OUT + 1024 * 1024, W_MV = W_MK + 1024 * 1024,
                 W_LAYER = W_MV + 1024 * 1024;
constexpr size_t WS_MPB = WS_W + W_LAYER * 2 * DEPTH;
constexpr size_t WS_TAB = WS_MPB + (size_t)2048 * 1024 * 2;
constexpr size_t WS_RSTDQ = WS_TAB + (size_t)4128 * 32 * 4;
constexpr size_t WS_END = WS_RSTDQ + (size_t)MT * 4;

#ifndef PH
#define PH 0xffff
#endif
constexpr int RING_BYTES = 131072, JT_OFF = RING_BYTES, LDS_BYTES = 147456;

struct Params { const float* in[31]; float* out; unsigned char* ws; };
constexpr int PARAM_OFF = 131072 + 1024;
struct PL {
    const volatile LAS unsigned* base;
    __device__ __forceinline__ unsigned long long ldp(int i) const { const unsigned lo = __builtin_amdgcn_readfirstlane(base[2 * i]), hi = __builtin_amdgcn_readfirstlane(base[2 * i + 1]); return ((unsigned long long)hi << 32) | lo; }
    __device__ __forceinline__ const float* in(int i) const { return (const float*)ldp(i); }
    __device__ __forceinline__ float* out() const { return (float*)ldp(31); }
    __device__ __forceinline__ unsigned char* ws() const { return (unsigned char*)ldp(32); }
};

__device__ __forceinline__ unsigned f2bf(float f) { unsigned u = __builtin_bit_cast(unsigned, f); return (u + 0x7fffu + ((u >> 16) & 1u)) >> 16; }
__device__ __forceinline__ unsigned pk2(float lo, float hi) { return f2bf(lo) | (f2bf(hi) << 16); }
__device__ __forceinline__ float bf2f(unsigned h) { return __builtin_bit_cast(float, h << 16); }
__device__ __forceinline__ float bflo(unsigned w) { return __builtin_bit_cast(float, w << 16); }
__device__ __forceinline__ float bfhi(unsigned w) { return __builtin_bit_cast(float, w & 0xffff0000u); }
__device__ __forceinline__ float ex2(float x) { return __builtin_amdgcn_exp2f(x); }
__device__ __forceinline__ float fexp(float x) { return __builtin_amdgcn_exp2f(x * LOG2E); }
__device__ __forceinline__ float sigm(float x) { return 1.0f / (1.0f + fexp(-x)); }
__device__ __forceinline__ float silu(float x) { return x * sigm(x); }
__device__ __forceinline__ bf16x8 pack8(float a, float b, float c, float d, float e, float f, float g, float h) {
    u32x4 w; w.x = pk2(a, b); w.y = pk2(c, d); w.z = pk2(e, f); w.w = pk2(g, h); return __builtin_bit_cast(bf16x8, w);
}
__device__ __forceinline__ bf16x8 pack8v(f32x4 a, f32x4 b) { return pack8(a.x, a.y, a.z, a.w, b.x, b.y, b.z, b.w); }
__device__ __forceinline__ bf16x8 cat8(u32x2 a, u32x2 b) { u32x4 w; w.x = a.x; w.y = a.y; w.z = b.x; w.w = b.y; return __builtin_bit_cast(bf16x8, w); }
__device__ __forceinline__ int crow(int r, int hi) { return (r & 3) + 8 * (r >> 2) + 4 * hi; }
__device__ __forceinline__ float wave_sum(float v) {
#pragma unroll
    for (int o = 1; o < 64; o <<= 1) v += __shfl_xor(v, o);
    return v;
}
__device__ __forceinline__ int opaque_tid() { int t = threadIdx.x; asm volatile("" : "+v"(t)); return t; }
__device__ __forceinline__ f32x16 mfma32(bf16x8 a, bf16x8 b, f32x16 c) { return __builtin_amdgcn_mfma_f32_32x32x16_bf16(a, b, c, 0, 0, 0); }

namespace pg8 {
constexpr int BM = 256, BK = 64, HALF = 128, HTB = HALF * BK * 2;
__device__ __forceinline__ int lds_byte(int r, int c) { const int st = (r >> 4) * 2 + (c >> 5), rr = r & 15, cc = c & 31, ob = rr * 64 + cc * 2; return st * 1024 + (ob ^ (((ob >> 9) & 1) << 5)); }
__device__ __forceinline__ void stage_rc(int b, int& R, int& C) { const int st = b / 1024, sb = b % 1024, swz = sb ^ (((sb >> 9) & 1) << 5); R = (st >> 1) * 16 + swz / 64; C = (st & 1) * 32 + (swz % 64) / 2; }
__device__ __forceinline__ int perm32(int rho) { const int n = rho >> 4, i = rho & 15; return 8 * (i >> 2) + 4 * n + (i & 3); }

enum { E_BF16 = 0, E_F32 = 1, E_QROPE = 2, E_MERGE = 3, E_OUT = 4 };
struct Job { const bf16_t* A; const bf16_t* Bt; void* O; const void* aux; const void* aux2; int lda, ldb, K, nM, nN, ldc, epi, auxi; };
struct Unit { int job, pm, pn; };

struct Sched {
    const LAS Job* jt; int nj, sub, G, c;
    __device__ __forceinline__ bool next(int i, Unit& u) const {
        int L, j = 0;
        if (sub > 1) { j = i % sub; L = (i / sub) * G + c; if (L >= jt[0].nM * jt[0].nN) return false; }
        else { L = i * G + c; for (;;) { if (j >= nj) return false; const int n = jt[j].nM * jt[j].nN; if (L < n) break; L -= n; ++j; } }
        const int nM = jt[j].nM, nN = jt[j].nN, nwg = nM * nN;
        int wgid = L; { const int q = nwg / 8, r = nwg % 8, xcd = wgid % 8, off = wgid / 8; wgid = (xcd < r ? xcd * (q + 1) : r * (q + 1) + (xcd - r) * q) + off; }
        const int nig = 8 * nN, gid = wgid / nig, fm = gid * 8, gsz = (nM - fm) < 8 ? (nM - fm) : 8;
        u.pm = __builtin_amdgcn_readfirstlane(fm + ((wgid % nig) % gsz)); u.pn = __builtin_amdgcn_readfirstlane((wgid % nig) / gsz); u.job = __builtin_amdgcn_readfirstlane(j); return true;
    }
};

__device__ __forceinline__ unsigned cvt_pk_bf16(float lo, float hi) { unsigned r; asm volatile("v_cvt_pk_bf16_f32 %0, %1, %2" : "=v"(r) : "v"(lo), "v"(hi)); return r; }

__device__ __forceinline__ void epilogue(const f32x4 (&acc)[2][2][4][2], const LAS Job* jb, const Unit& u, int wr, int wc, int fr, int fq) {
    const int epi = jb->epi, ldc = jb->ldc;
    const int row0 = u.pm * BM + wr * 64 + fr, col0 = u.pn * BM + wc * 32 + 8 * fq;
    if (epi == E_BF16) {
        bf16_t* O = (bf16_t*)jb->O;
#pragma unroll
        for (int ai = 0; ai < 2; ++ai)
#pragma unroll
            for (int m = 0; m < 4; ++m) { bf16_t* rowp = O + (size_t)(row0 + ai * HALF + m * 16) * ldc + col0;
#pragma unroll
                for (int bj = 0; bj < 2; ++bj) { const f32x4 v0 = acc[ai][bj][m][0], v1 = acc[ai][bj][m][1]; u32x4 w; w.x = cvt_pk_bf16(v0[0], v0[1]); w.y = cvt_pk_bf16(v0[2], v0[3]); w.z = cvt_pk_bf16(v1[0], v1[1]); w.w = cvt_pk_bf16(v1[2], v1[3]);
                    *(u32x4*)(rowp + bj * HALF) = w; } }
    } else if (epi == E_F32) {
        float* O = (float*)jb->O;
#pragma unroll
        for (int ai = 0; ai < 2; ++ai)
#pragma unroll
            for (int m = 0; m < 4; ++m) { float* rowp = O + (size_t)(row0 + ai * HALF + m * 16) * ldc + col0;
#pragma unroll
                for (int bj = 0; bj < 2; ++bj) { *(f32x4*)(rowp + bj * HALF) = acc[ai][bj][m][0]; *(f32x4*)(rowp + bj * HALF + 4) = acc[ai][bj][m][1]; } }
    } else if (epi == E_OUT) {
        float* O = (float*)jb->O;
#pragma unroll
        for (int ai = 0; ai < 2; ++ai)
#pragma unroll
            for (int m = 0; m < 4; ++m) { float* rowp = O + (size_t)(row0 + ai * HALF + m * 16) * ldc + col0;
#pragma unroll
                for (int bj = 0; bj < 2; ++bj) { const f32x4 x0 = *(const f32x4*)(rowp + bj * HALF), x1 = *(const f32x4*)(rowp + bj * HALF + 4);
                    *(f32x4*)(rowp + bj * HALF) = x0 * ALPHA + acc[ai][bj][m][0]; *(f32x4*)(rowp + bj * HALF + 4) = x1 * ALPHA + acc[ai][bj][m][1]; }
                asm volatile("" ::: "memory"); }
    } else if (epi == E_MERGE) {
        bf16_t* O = (bf16_t*)jb->O; const bf16_t* G = (const bf16_t*)jb->aux; const int first = (jb->auxi == 0);
#pragma unroll
        for (int ai = 0; ai < 2; ++ai)
#pragma unroll
            for (int m = 0; m < 4; ++m) { const size_t ro = (size_t)(row0 + ai * HALF + m * 16) * ldc + col0;
#pragma unroll
                for (int bj = 0; bj < 2; ++bj) { const u32x4 g = *(const u32x4*)(G + ro + bj * HALF); u32x4 h = (u32x4){0u, 0u, 0u, 0u}; if (!first) h = *(const u32x4*)(O + ro + bj * HALF);
                    const f32x4 v0 = acc[ai][bj][m][0], v1 = acc[ai][bj][m][1]; u32x4 w;
                    w.x = pk2(bflo(h.x) + sigm(bflo(g.x)) * v0[0], bfhi(h.x) + sigm(bfhi(g.x)) * v0[1]);
                    w.y = pk2(bflo(h.y) + sigm(bflo(g.y)) * v0[2], bfhi(h.y) + sigm(bfhi(g.y)) * v0[3]);
                    w.z = pk2(bflo(h.z) + sigm(bflo(g.z)) * v1[0], bfhi(h.z) + sigm(bfhi(g.z)) * v1[1]);
                    w.w = pk2(bflo(h.w) + sigm(bflo(g.w)) * v1[2], bfhi(h.w) + sigm(bfhi(g.w)) * v1[3]);
                    *(u32x4*)(O + ro + bj * HALF) = w; }
                asm volatile("" ::: "memory"); }
    } else {
        bf16_t* O = (bf16_t*)jb->O; const float* RS = (const float*)jb->aux; const float* TAB = (const float*)jb->aux2;
#pragma unroll
        for (int ai = 0; ai < 2; ++ai)
#pragma unroll
            for (int m = 0; m < 4; ++m) { const int row = row0 + ai * HALF + m * 16; const float rs = RS[row];
                const int pos = row < MP ? (row & (SEQ - 1)) : PAST + ((row - MP) & (DSEQ - 1));
#pragma unroll
                for (int bj = 0; bj < 2; ++bj) { const int gc = col0 + bj * HALF; f32x4 v0 = acc[ai][bj][m][0] * rs, v1 = acc[ai][bj][m][1] * rs;
                    if (((gc >> 5) % 3) == 2) {
                        const float* tp = TAB + ((size_t)pos * 16 + 8 * (fq & 1)) * 2; const f32x4 t0 = *(const f32x4*)tp, t1 = *(const f32x4*)(tp + 4), t2 = *(const f32x4*)(tp + 8), t3 = *(const f32x4*)(tp + 12);
                        f32x4 p0, p1;
#pragma unroll
                        for (int e = 0; e < 4; ++e) { p0[e] = __shfl_xor(v0[e], 32); p1[e] = __shfl_xor(v1[e], 32); }
                        const float sg = (fq >> 1) ? 1.f : -1.f;
                        v0 = (f32x4){v0[0] * t0[0] + sg * p0[0] * t0[1], v0[1] * t0[2] + sg * p0[1] * t0[3], v0[2] * t1[0] + sg * p0[2] * t1[1], v0[3] * t1[2] + sg * p0[3] * t1[3]};
                        v1 = (f32x4){v1[0] * t2[0] + sg * p1[0] * t2[1], v1[1] * t2[2] + sg * p1[1] * t2[3], v1[2] * t3[0] + sg * p1[2] * t3[1], v1[3] * t3[2] + sg * p1[3] * t3[3]};
                    }
                    u32x4 w; w.x = pk2(v0[0], v0[1]); w.y = pk2(v0[2], v0[3]); w.z = pk2(v1[0], v1[1]); w.w = pk2(v1[2], v1[3]);
                    *(u32x4*)(O + (size_t)row * ldc + gc) = w; }
                asm volatile("" ::: "memory"); }
    }
}

struct UP { const char* A; const char* B; unsigned la2, lb2; int nt; };
__device__ __forceinline__ void load_up(UP& p, const LAS Job* jt, const Unit& u) {
    const LAS Job* jb = jt + u.job; const int lda = __builtin_amdgcn_readfirstlane(jb->lda), ldb = __builtin_amdgcn_readfirstlane(jb->ldb);
    p.A = (const char*)jb->A + (size_t)u.pm * 256 * lda * 2; p.B = (const char*)jb->Bt + (size_t)u.pn * 256 * ldb * 2;
    p.la2 = (unsigned)(lda * 2); p.lb2 = (unsigned)(ldb * 2);
    p.nt = __builtin_amdgcn_readfirstlane(jb->K / BK);
}

__device__ __forceinline__ void gemm_phase(LAS unsigned char* lds, const LAS Job* jt, const Sched& S) {
    const int tid = opaque_tid(), wid = __builtin_amdgcn_readfirstlane(tid >> 6), lane = tid & 63, wr = wid >> 2, wc = wid & 3, fr = lane & 15, fq = lane >> 4;
    int R0, C0; stage_rc(tid * 16, R0, C0); const int Rb0 = (R0 & ~31) + perm32(R0 & 31); const unsigned C2 = (unsigned)C0 * 2u;
    const size_t kstep = (size_t)(BK * 2);
    const unsigned ldsw = (unsigned)wid * 1024u;
    const int aoff = lds_byte(wr * 64 + fr, fq * 8), boff = lds_byte(wc * 32 + fr, fq * 8);
#define PG8_SA(b, h) (((b) * 2 + (h)) * HTB)
#define PG8_SB(b, h) ((4 + (b) * 2 + (h)) * HTB)
#define PG8_STAGE(bufoff, gbase, RR, ld2) do { const unsigned v_ = (unsigned)(RR) * (ld2) + C2; \
        __builtin_amdgcn_global_load_lds((const unsigned*)((const char*)(gbase) + v_), (LAS unsigned*)(lds + (bufoff) + ldsw), 16, 0, 0); \
        __builtin_amdgcn_global_load_lds((const unsigned*)((const char*)(gbase) + 64u * (ld2) + v_), (LAS unsigned*)(lds + (bufoff) + ldsw + 8192), 16, 0, 0); } while (0)
#define PG8_LDA(dst, b, h) do { _Pragma("unroll") for (int m = 0; m < 4; ++m) _Pragma("unroll") for (int k = 0; k < 2; ++k) dst[m][k] = *(const LAS bf16x8*)(lds + PG8_SA(b, h) + aoff + m * 2048 + k * 1024); } while (0)
#define PG8_LDB(dst, b, h) do { _Pragma("unroll") for (int n = 0; n < 2; ++n) _Pragma("unroll") for (int k = 0; k < 2; ++k) dst[n][k] = *(const LAS bf16x8*)(lds + PG8_SB(b, h) + boff + n * 2048 + k * 1024); } while (0)
#define PG8_MMA(ai, bj, At, Bt) do { __builtin_amdgcn_s_setprio(1); _Pragma("unroll") for (int m = 0; m < 4; ++m) _Pragma("unroll") for (int n = 0; n < 2; ++n) _Pragma("unroll") for (int k = 0; k < 2; ++k) \
        acc[ai][bj][m][n] = __builtin_amdgcn_mfma_f32_16x16x32_bf16(Bt[n][k], At[m][k], acc[ai][bj][m][n], 0, 0, 0); __builtin_amdgcn_s_setprio(0); } while (0)
#define PG8_WAIT_V(n) asm volatile("s_waitcnt vmcnt(" #n ")" ::: "memory")
#define PG8_WAIT_L(n) asm volatile("s_waitcnt lgkmcnt(" #n ")" ::: "memory")
#define PG8_BAR __builtin_amdgcn_s_barrier()
#define PG8_SCHED __builtin_amdgcn_sched_barrier(0)
    Unit cur, nxt; int ui = 0;
    if (!S.next(0, cur)) return;
    UP pc, pn; load_up(pc, jt, cur);
    f32x4 acc[2][2][4][2];
#pragma unroll
    for (int a = 0; a < 2; ++a)
#pragma unroll
        for (int b = 0; b < 2; ++b)
#pragma unroll
            for (int m = 0; m < 4; ++m)
#pragma unroll
                for (int n = 0; n < 2; ++n) acc[a][b][m][n] = (f32x4){0.f, 0.f, 0.f, 0.f};
    bf16x8 At[4][2], B0[2][2], B1[2][2];
    {
        const char* cA = pc.A; const char* cB = pc.B;
        PG8_STAGE(PG8_SB(0, 0), cB, Rb0, pc.lb2); PG8_STAGE(PG8_SB(0, 1), cB + 128u * pc.lb2, Rb0, pc.lb2); PG8_STAGE(PG8_SA(0, 0), cA, R0, pc.la2); PG8_STAGE(PG8_SA(0, 1), cA + 128u * pc.la2, R0, pc.la2);
        if (wr == 1) PG8_BAR;
        PG8_WAIT_V(2); PG8_BAR;
        PG8_STAGE(PG8_SB(1, 0), cB + kstep, Rb0, pc.lb2); PG8_STAGE(PG8_SA(1, 0), cA + kstep, R0, pc.la2); PG8_STAGE(PG8_SB(1, 1), cB + 128u * pc.lb2 + kstep, Rb0, pc.lb2);
        PG8_WAIT_V(6); PG8_BAR;
    }
    for (;;) {
        const bool has_next = S.next(ui + 1, nxt);
        if (has_next) load_up(pn, jt, nxt); else pn = pc;
        const char* cA = pc.A; const char* cB = pc.B; const int nt = pc.nt;
        for (int t = 0; t < nt; t += 2) {
            const bool last = (t == nt - 2);
            const char* a1 = cA + (size_t)(t + 1) * kstep;
            const char* a2 = last ? pn.A : cA + (size_t)(t + 2) * kstep; const char* b2 = last ? pn.B : cB + (size_t)(t + 2) * kstep;
            const char* a3 = a2 + kstep; const char* b3 = b2 + kstep;
            const unsigned la2 = last ? pn.la2 : pc.la2, lb2 = last ? pn.lb2 : pc.lb2;
            PG8_LDB(B0, 0, 0); PG8_LDB(B1, 0, 1); PG8_SCHED; PG8_LDA(At, 0, 0); PG8_STAGE(PG8_SA(1, 1), a1 + 128u * pc.la2, R0, pc.la2);
            PG8_WAIT_V(8); PG8_WAIT_L(0); PG8_BAR; PG8_MMA(0, 0, At, B0); PG8_MMA(0, 1, At, B1); PG8_BAR; PG8_SCHED;
            PG8_LDA(At, 0, 1); PG8_STAGE(PG8_SB(0, 0), b2, Rb0, lb2); PG8_STAGE(PG8_SB(0, 1), b2 + 128u * lb2, Rb0, lb2); PG8_STAGE(PG8_SA(0, 0), a2, R0, la2);
            PG8_WAIT_V(8); PG8_WAIT_L(0); PG8_BAR; PG8_MMA(1, 0, At, B0); PG8_MMA(1, 1, At, B1); PG8_BAR; PG8_SCHED;
            PG8_LDB(B0, 1, 0); PG8_LDB(B1, 1, 1); PG8_SCHED; PG8_LDA(At, 1, 0); PG8_STAGE(PG8_SA(0, 1), a2 + 128u * la2, R0, la2);
            PG8_WAIT_V(8); PG8_WAIT_L(0); PG8_BAR; PG8_MMA(0, 0, At, B0); PG8_MMA(0, 1, At, B1); PG8_BAR; PG8_SCHED;
            PG8_LDA(At, 1, 1); PG8_STAGE(PG8_SB(1, 0), b3, Rb0, lb2); PG8_STAGE(PG8_SB(1, 1), b3 + 128u * lb2, Rb0, lb2); PG8_STAGE(PG8_SA(1, 0), a3, R0, la2);
            PG8_WAIT_V(8); PG8_WAIT_L(0); PG8_BAR; PG8_MMA(1, 0, At, B0); PG8_MMA(1, 1, At, B1); PG8_BAR; PG8_SCHED;
        }
        if (wr == 0) PG8_BAR;
        epilogue(acc, jt + cur.job, cur, wr, wc, fr, fq);
        if (!has_next) break;
#pragma unroll
        for (int a = 0; a < 2; ++a)
#pragma unroll
            for (int b = 0; b < 2; ++b)
#pragma unroll
                for (int m = 0; m < 4; ++m)
#pragma unroll
                    for (int n = 0; n < 2; ++n) acc[a][b][m][n] = (f32x4){0.f, 0.f, 0.f, 0.f};
        cur = nxt; pc = pn; ++ui;
        if (wr == 1) PG8_BAR;
    }
    PG8_WAIT_V(0);
    PG8_BAR;
#undef PG8_SA
#undef PG8_SB
#undef PG8_STAGE
#undef PG8_LDA
#undef PG8_LDB
#undef PG8_MMA
#undef PG8_WAIT_V
#undef PG8_WAIT_L
#undef PG8_BAR
#undef PG8_SCHED
}
}

__device__ __forceinline__ void transpose_item(const float* W, int K, int N, bf16_t* WT, int kb, int ns, int nd, const float* sk, LAS float* scr, int lane) {
    const int k0 = 64 * kb;
#pragma unroll 8
    for (int i = 0; i < 32; ++i) { const int kk = 2 * i + (lane >> 5); float v = 0.f; if (ns >= 0) { v = W[(size_t)(k0 + kk) * N + ns + (lane & 31)]; if (sk) v *= sk[k0 + kk]; } scr[kk * 33 + (lane & 31)] = v; }
    asm volatile("s_waitcnt lgkmcnt(0)" ::: "memory");
    const int c = lane & 7;
#pragma unroll
    for (int j = 0; j < 4; ++j) { const int n = (lane >> 3) + 8 * j; const LAS float* s = scr + (8 * c) * 33 + n;
        u32x4 o; o.x = pk2(s[0 * 33], s[1 * 33]); o.y = pk2(s[2 * 33], s[3 * 33]); o.z = pk2(s[4 * 33], s[5 * 33]); o.w = pk2(s[6 * 33], s[7 * 33]);
        *(u32x4*)(WT + (size_t)(nd + n) * K + k0 + 8 * c) = o; }
    asm volatile("s_waitcnt lgkmcnt(0)" ::: "memory");
}
__device__ __forceinline__ int win_src(int n) {
    if (n < 5120) return n;
    if (n < 5632) return n - 5120 + 5152;
    if (n < 5888) return n - 5632 + 5664;
    if (n < 6912) return n - 5888 + 5952;
    if (n < 7936) return n - 6912 + 6976;
    if (n < 11008) return n - 7936 + 8000;
    if (n < 11040) return n - 11008 + 5120;
    if (n < 11072) return n - 11040 + 5920;
    return -1;
}
__device__ __forceinline__ void ln_row(const float* src, const float* g, const float* b, float* dstf, bf16_t* dstb, int lane) {
    const f32x4* xr = (const f32x4*)src + lane; f32x4 v[4]; float s = 0.f;
#pragma unroll
    for (int j = 0; j < 4; ++j) { v[j] = xr[64 * j]; s += (v[j].x + v[j].y) + (v[j].z + v[j].w); }
    const float mean = wave_sum(s) * (1.f / DM); float s2 = 0.f;
#pragma unroll
    for (int j = 0; j < 4; ++j) { v[j] = v[j] - mean; s2 += (v[j].x * v[j].x + v[j].y * v[j].y) + (v[j].z * v[j].z + v[j].w * v[j].w); }
    const float rstd = 1.f / sqrtf(wave_sum(s2) * (1.f / DM) + LN_EPS);
#pragma unroll
    for (int j = 0; j < 4; ++j) { const f32x4 gg = ((const f32x4*)g)[lane + 64 * j], bb = ((const f32x4*)b)[lane + 64 * j]; const f32x4 o = v[j] * rstd * gg + bb;
        ((f32x4*)dstf)[lane + 64 * j] = o; u32x2 w; w.x = pk2(o.x, o.y); w.y = pk2(o.z, o.w); ((u32x2*)dstb)[lane + 64 * j] = w; }
}

template <int KS, int DVB, class KL, class VL>
__device__ __forceinline__ void attn_half(f32x16 (&o)[DVB], float& mrun, float& lrun, const bf16x8 (&q)[KS], float sc, KL kl, VL vl) {
    f32x16 st;
#pragma unroll
    for (int r = 0; r < 16; ++r) st[r] = 0.f;
#pragma unroll
    for (int s = 0; s < KS; ++s) st = mfma32(kl(s), q[s], st);
    float mx = st[0];
#pragma unroll
    for (int r = 1; r < 16; ++r) mx = fmaxf(mx, st[r]);
    mx = fmaxf(mx, __shfl_xor(mx, 32));
    const float mnew = fmaxf(mrun, mx);
    const float alpha = ex2((mrun - mnew) * sc);
    const float mb = mnew * sc; float ps = 0.f;
#pragma unroll
    for (int r = 0; r < 16; ++r) { st[r] = ex2(st[r] * sc - mb); ps += st[r]; }
    lrun = lrun * alpha + ps; mrun = mnew;
#pragma unroll
    for (int d = 0; d < DVB; ++d) o[d] = o[d] * alpha;
    const bf16x8 p0 = pack8(st[0], st[1], st[2], st[3], st[4], st[5], st[6], st[7]), p1 = pack8(st[8], st[9], st[10], st[11], st[12], st[13], st[14], st[15]);
#pragma unroll
    for (int d = 0; d < DVB; ++d) { o[d] = mfma32(vl(d, 0), p0, o[d]); o[d] = mfma32(vl(d, 1), p1, o[d]); }
}

__device__ __forceinline__ bf16x8 ld_f32x8(const float* p) { return pack8v(*(const f32x4*)p, *(const f32x4*)(p + 4)); }
__device__ __forceinline__ bf16x8 ld_f32_44(const float* p) { return pack8v(*(const f32x4*)p, *(const f32x4*)(p + 8)); }
__device__ __forceinline__ bf16x8 ld_f32_strided(const float* p, int pitch) {
    return pack8(p[0], p[pitch], p[2 * pitch], p[3 * pitch], p[8 * pitch], p[9 * pitch], p[10 * pitch], p[11 * pitch]);
}

template <int DVB, bool GATE>
__device__ __forceinline__ void attn_store(const f32x16 (&o)[DVB], float inv, bf16_t* rowp  , int hi) {
#pragma unroll
    for (int d = 0; d < DVB; ++d)
#pragma unroll
        for (int g4 = 0; g4 < 4; ++g4) { bf16_t* p = rowp + 32 * d + 8 * g4 + 4 * hi; float v0 = o[d][4 * g4] * inv, v1 = o[d][4 * g4 + 1] * inv, v2 = o[d][4 * g4 + 2] * inv, v3 = o[d][4 * g4 + 3] * inv;
            if (GATE) { const u32x2 g = *(const u32x2*)p; v0 *= silu(bflo(g.x)); v1 *= silu(bfhi(g.x)); v2 *= silu(bflo(g.y)); v3 *= silu(bfhi(g.y)); }
            u32x2 w; w.x = pk2(v0, v1); w.y = pk2(v2, v3); *(u32x2*)p = w; }
}

__device__ __forceinline__ void mla_prompt_wave(bf16_t* PJ, const bf16_t* VT, int b, int h, int q0, int lane_in) {
    const int lane = opaque_tid() & 63; const int l31 = lane & 31, hi = lane >> 5;
    bf16_t* qrow = PJ + (size_t)((size_t)b * SEQ + q0 + l31) * NPJ;
    bf16x8 q[6];
#pragma unroll
    for (int s = 0; s < 6; ++s) q[s] = *(const bf16x8*)(qrow + C_Q + h * 96 + 16 * s + 8 * hi);
    f32x16 o[2];
#pragma unroll
    for (int r = 0; r < 16; ++r) { o[0][r] = 0.f; o[1][r] = 0.f; }
    float mrun = -INFINITY, lrun = 0.f;
    const int nhalf = 2 * ((q0 >> 6) + 1);
    for (int hf = 0; hf < nhalf; ++hf) {
        const bf16_t* krow = PJ + (size_t)((size_t)b * SEQ + hf * 32 + l31) * NPJ;
        const bf16_t* vbase = VT + (size_t)(h * 64 + l31) * MP + (size_t)b * SEQ + hf * 32 + 4 * hi;
        auto kl = [&](int s) -> bf16x8 { return s < 4 ? *(const bf16x8*)(krow + C_KN + h * 64 + 16 * s + 8 * hi) : *(const bf16x8*)(krow + C_KR + (s - 4) * 16 + 8 * hi); };
        auto vl = [&](int d, int j) -> bf16x8 { const bf16_t* vp = vbase + (size_t)(32 * d) * MP + 16 * j; return cat8(*(const u32x2*)vp, *(const u32x2*)(vp + 8)); };
        attn_half<6, 2>(o, mrun, lrun, q, MLA_SC, kl, vl);
    }
    const float lt = lrun + __shfl_xor(lrun, 32);
    attn_store<2, true>(o, 1.f / lt, qrow + C_GM + h * 64, hi);
}

__device__ __forceinline__ void mem_attn_wave(bf16_t* PJ, const float* KB, const float* VB, int r0, int h, int lane_in) {
    const int lane = opaque_tid() & 63; const int l31 = lane & 31, hi = lane >> 5;
    bf16_t* qrow = PJ + (size_t)(r0 + l31) * NPJ;
    bf16x8 q[16];
#pragma unroll
    for (int s = 0; s < 16; ++s) q[s] = *(const bf16x8*)(qrow + C_QM + h * 256 + 16 * s + 8 * hi);
    for (int dp = 0; dp < 2; ++dp) {
        f32x16 o[4];
#pragma unroll
        for (int d = 0; d < 4; ++d)
#pragma unroll
            for (int r = 0; r < 16; ++r) o[d][r] = 0.f;
        float mrun = -INFINITY, lrun = 0.f;
        for (int hf = 0; hf < 8; ++hf) {
            const float* kp = KB + (size_t)(hf * 32 + l31) * 1024 + h * 256 + 8 * hi;
            const float* vp0 = VB + (size_t)(hf * 32 + 4 * hi) * 1024 + h * 256 + dp * 128 + l31;
            auto kl = [&](int s) -> bf16x8 { return ld_f32x8(kp + 16 * s); };
            auto vl = [&](int d, int j) -> bf16x8 { return ld_f32_strided(vp0 + (size_t)(16 * j) * 1024 + 32 * d, 1024); };
            attn_half<16, 4>(o, mrun, lrun, q, MEM_SC, kl, vl);
        }
        const float lt = lrun + __shfl_xor(lrun, 32);
        attn_store<4, false>(o, 1.f / lt, qrow + C_QM + h * 256 + dp * 128, hi);
    }
}

__device__ __forceinline__ void mla_sample_wave(const PL& P, bf16_t* PJ, const bf16_t* WUVT, int layer, int b, int h, int lane_in) {
    const int lane = opaque_tid() & 63; const int l31 = lane & 31, hi = lane >> 5;
    bf16_t* qrow = PJ + (size_t)(MP + b * DSEQ + l31) * NPJ;
    bf16x8 q[18];
    {
        bf16x8 qn[4];
#pragma unroll
        for (int s = 0; s < 4; ++s) qn[s] = *(const bf16x8*)(qrow + C_Q + h * 96 + 16 * s + 8 * hi);
        const float* wuk = P.in(22) + (size_t)layer * 256 * 1024 + h * 64 + 8 * hi;
#pragma unroll
        for (int cb = 0; cb < 8; ++cb) { f32x16 a;
#pragma unroll
            for (int r = 0; r < 16; ++r) a[r] = 0.f;
#pragma unroll
            for (int s = 0; s < 4; ++s) a = mfma32(ld_f32x8(wuk + (size_t)(32 * cb + l31) * 1024 + 16 * s), qn[s], a);
            q[2 * cb] = pack8(a[0], a[1], a[2], a[3], a[4], a[5], a[6], a[7]); q[2 * cb + 1] = pack8(a[8], a[9], a[10], a[11], a[12], a[13], a[14], a[15]); }
        q[16] = *(const bf16x8*)(qrow + C_Q + h * 96 + 64 + 8 * hi); q[17] = *(const bf16x8*)(qrow + C_Q + h * 96 + 80 + 8 * hi);
    }
    const float* cckv = P.in(5) + (size_t)(layer * NSB + b) * PAST * 256; const float* ckr = P.in(6) + (size_t)(layer * NSB + b) * PAST * 32;
    const float* nckv = P.out() + O_SCKV + (size_t)(layer * NSB + b) * DSEQ * 256; const float* nkr = P.out() + O_SKR + (size_t)(layer * NSB + b) * DSEQ * 32;
    f32x16 oT[2];
#pragma unroll
    for (int r = 0; r < 16; ++r) { oT[0][r] = 0.f; oT[1][r] = 0.f; }
    float lt = 1.f;
    for (int ch = 0; ch < 2; ++ch) {
        f32x16 o[4];
#pragma unroll
        for (int d = 0; d < 4; ++d)
#pragma unroll
            for (int r = 0; r < 16; ++r) o[d][r] = 0.f;
        float mrun = -INFINITY, lrun = 0.f;
        for (int hf = 0; hf < 129; ++hf) {
            const float* kb = hf < 128 ? cckv + (size_t)hf * 32 * 256 : nckv; const float* rb = hf < 128 ? ckr + (size_t)hf * 32 * 32 : nkr;
            const float* kp = kb + (size_t)l31 * 256 + 4 * hi; const float* rp = rb + (size_t)l31 * 32 + 8 * hi;
            const float* vp0 = kb + (size_t)(4 * hi) * 256 + ch * 128 + l31;
            auto kl = [&](int s) -> bf16x8 { return s < 16 ? ld_f32_44(kp + 16 * s) : ld_f32x8(rp + (s - 16) * 16); };
            auto vl = [&](int d, int j) -> bf16x8 { return ld_f32_strided(vp0 + (size_t)(16 * j) * 256 + 32 * d, 256); };
            attn_half<18, 4>(o, mrun, lrun, q, MLA_SC, kl, vl);
        }
        lt = lrun + __shfl_xor(lrun, 32);
#pragma unroll
        for (int d = 0; d < 4; ++d) { const int cb = 4 * ch + d;
            const bf16x8 p0 = pack8(o[d][0], o[d][1], o[d][2], o[d][3], o[d][4], o[d][5], o[d][6], o[d][7]), p1 = pack8(o[d][8], o[d][9], o[d][10], o[d][11], o[d][12], o[d][13], o[d][14], o[d][15]);
#pragma unroll
            for (int db = 0; db < 2; ++db) { const bf16_t* wp = WUVT + (size_t)(h * 64 + 32 * db + l31) * 256 + 32 * cb + 4 * hi;
                oT[db] = mfma32(cat8(*(const u32x2*)wp, *(const u32x2*)(wp + 8)), p0, oT[db]);
                oT[db] = mfma32(cat8(*(const u32x2*)(wp + 16), *(const u32x2*)(wp + 24)), p1, oT[db]); } }
    }
    attn_store<2, true>(oT, 1.f / lt, qrow + C_GM + h * 64, hi);
}

__device__ __forceinline__ float wave_incl_scan(float v, int lane) {
#pragma unroll
    for (int o = 1; o < 64; o <<= 1) { const float t = __shfl_up(v, o); if (lane >= o) v += t; }
    return v;
}
__device__ __forceinline__ void ssd_unit(const PL& P, int layer, int sample, int b, int hd, unsigned char* lds, int tid_in, int wave, int lane_in) {
    const int g = hd >> 3; int tid = tid_in, lane = lane_in, l31 = lane & 31, hi = lane >> 5;
    const size_t rowbase = sample ? (size_t)(MP + b * DSEQ) : (size_t)b * SEQ;
    const int nchunk = sample ? 1 : 64, nvalid = sample ? 32 : 64;
    bf16_t* PJ = (bf16_t*)(P.ws() + WS_PROJ);
    const float a_h = -__expf(P.in(15)[layer * 32 + hd]), dtb = P.in(14)[layer * 32 + hd], dsk = P.in(16)[layer * 32 + hd];
    constexpr int PW = 136, PN = 72;
    bf16_t* CM = (bf16_t*)lds; bf16_t* BMs = CM + 64 * PW; bf16_t* BT = BMs + 64 * PW; bf16_t* XT = BT + 128 * PN; bf16_t* XS = XT + 64 * PN; bf16_t* HB = XS + 64 * PN;
    float* CWT = (float*)(lds + 90112);
    for (int i = tid; i < 1600; i += 512) { const int o_ = i / 40, r_ = i % 40, k_ = r_ >> 3, j_ = r_ & 7;
        const int xc_ = (o_ < 8 ? hd * 64 + o_ * 8 : (o_ < 24 ? 2048 + g * 128 + (o_ - 8) * 8 : 2560 + g * 128 + (o_ - 24) * 8)) + j_;
        CWT[i] = r_ < 32 ? P.in(12)[(size_t)(layer * 4 + k_) * 3072 + xc_] : P.in(13)[(size_t)layer * 3072 + xc_]; }
    const int ph = wave >> 2, nq = wave & 3;
    f32x16 Hacc;
    if (sample) { const float* sp = P.in(3) + ((size_t)(layer * NSB + b) * 32 + hd) * 8192;
#pragma unroll
        for (int r = 0; r < 16; ++r) Hacc[r] = sp[(32 * ph + crow(r, hi)) * 128 + 32 * nq + l31]; }
    else {
#pragma unroll
        for (int r = 0; r < 16; ++r) Hacc[r] = 0.f; }
#pragma unroll
    for (int r = 0; r < 16; ++r) HB[(32 * ph + crow(r, hi)) * PW + 32 * nq + l31] = (bf16_t)f2bf(Hacc[r]);
    __syncthreads();

    for (int ch = 0; ch < nchunk; ++ch) {
        const int t0 = ch * 64;
        tid = tid_in; asm volatile("" : "+v"(tid)); lane = tid & 63; l31 = lane & 31; hi = lane >> 5;
        const int oct = tid % 40, rg = tid / 40;
        const int xcol = oct < 8 ? hd * 64 + oct * 8 : (oct < 24 ? 2048 + g * 128 + (oct - 8) * 8 : 2560 + g * 128 + (oct - 24) * 8);
        float dtl = 0.f;
        if (lane < nvalid) { const float raw = bf2f(PJ[(rowbase + t0 + lane) * NPJ + C_DT + hd]) + dtb; dtl = raw > 20.f ? raw : log1pf(__expf(raw)); }
        const float acs = wave_incl_scan(dtl * a_h, lane);
        const float acs63 = __shfl(acs, 63);
        if (tid < 320) {
            u32x4 raw[11];
#pragma unroll
            for (int i = 0; i < 11; ++i) { const int tt = t0 + rg * 8 + i - 3;
                u32x4 v = (u32x4){0u, 0u, 0u, 0u};
                if (tt >= 0) { if (tt < (sample ? DSEQ : SEQ)) v = *(const u32x4*)(PJ + (rowbase + tt) * NPJ + C_XBC + xcol); }
                else if (sample) { const float* sp = P.in(4) + ((size_t)(layer * NSB + b) * 3 + (3 + tt)) * 3072 + xcol; const f32x4 a = *(const f32x4*)sp, c = *(const f32x4*)(sp + 4);
                    v.x = pk2(a.x, a.y); v.y = pk2(a.z, a.w); v.z = pk2(c.x, c.y); v.w = pk2(c.z, c.w); }
                raw[i] = v; }
            if (ch == nchunk - 1 && rg == (nvalid >> 3) - 1 && (oct < 8 || (hd & 7) == 0)) {
                float* cp = sample ? P.out() + O_SCONV + (size_t)(layer * NSB + b) * 3 * 3072 + xcol : P.out() + O_PCONV + (size_t)(layer * NB + b) * 3 * 3072 + xcol;
#pragma unroll
                for (int k = 0; k < 3; ++k) { const u32x4 v = raw[8 + k]; *(f32x4*)(cp + (size_t)k * 3072) = (f32x4){bflo(v.x), bfhi(v.x), bflo(v.y), bfhi(v.y)}; *(f32x4*)(cp + (size_t)k * 3072 + 4) = (f32x4){bflo(v.z), bfhi(v.z), bflo(v.w), bfhi(v.w)}; }
            }
            unsigned tp[8][4];
#pragma unroll
            for (int i = 0; i < 8; ++i) {
                const int tt = rg * 8 + i;
                float y[8];
                { const f32x4 b0 = *(const f32x4*)(CWT + oct * 40 + 32), b1 = *(const f32x4*)(CWT + oct * 40 + 36); y[0] = b0.x; y[1] = b0.y; y[2] = b0.z; y[3] = b0.w; y[4] = b1.x; y[5] = b1.y; y[6] = b1.z; y[7] = b1.w; }
#pragma unroll
                for (int k = 0; k < 4; ++k) { const u32x4 v = raw[i + k]; const f32x4 w0 = *(const f32x4*)(CWT + oct * 40 + k * 8), w1 = *(const f32x4*)(CWT + oct * 40 + k * 8 + 4);
                    y[0] += w0.x * bflo(v.x); y[1] += w0.y * bfhi(v.x); y[2] += w0.z * bflo(v.y); y[3] += w0.w * bfhi(v.y);
                    y[4] += w1.x * bflo(v.z); y[5] += w1.y * bfhi(v.z); y[6] += w1.z * bflo(v.w); y[7] += w1.w * bfhi(v.w); }
                asm volatile("" ::: "memory");
#pragma unroll
                for (int j = 0; j < 8; ++j) y[j] = silu(y[j]);
                const float dt_t = __shfl(dtl, tt), acs_t = __shfl(acs, tt);
                u32x4 w; w.x = pk2(y[0], y[1]); w.y = pk2(y[2], y[3]); w.z = pk2(y[4], y[5]); w.w = pk2(y[6], y[7]);
                float sc = 1.f;
                if (oct < 8) { *(u32x4*)(XS + tt * PN + oct * 8) = w; sc = dt_t; }
                else if (oct < 24) { *(u32x4*)(BMs + tt * PW + (oct - 8) * 8) = w; sc = fexp(acs63 - acs_t); }
                else { *(u32x4*)(CM + tt * PW + (oct - 24) * 8) = w; }
#pragma unroll
                for (int j = 0; j < 8; ++j) { const unsigned hv = f2bf(y[j] * sc); if (i & 1) tp[j][i >> 1] |= hv << 16; else tp[j][i >> 1] = hv; }
            }
            if (oct < 8) {
#pragma unroll
                for (int j = 0; j < 8; ++j) *(u32x4*)(XT + (oct * 8 + j) * PN + rg * 8) = (u32x4){tp[j][0], tp[j][1], tp[j][2], tp[j][3]};
            } else if (oct < 24) {
#pragma unroll
                for (int j = 0; j < 8; ++j) *(u32x4*)(BT + ((oct - 8) * 8 + j) * PN + rg * 8) = (u32x4){tp[j][0], tp[j][1], tp[j][2], tp[j][3]};
            }
        }
        __syncthreads();
        {
            const float dec = fexp(acs63);
#pragma unroll
            for (int r = 0; r < 16; ++r) Hacc[r] *= dec;
        }
        f32x16 Hn = Hacc;
#pragma unroll
        for (int ks = 0; ks < 4; ++ks) Hn = mfma32(*(const bf16x8*)(XT + (32 * ph + l31) * PN + 16 * ks + 8 * hi), *(const bf16x8*)(BT + (32 * nq + l31) * PN + 16 * ks + 8 * hi), Hn);
        Hacc = Hn;
        if (wave < 4) {
            const int lb = wave >> 1, pb = wave & 1;
            if (32 * lb < nvalid) {
                const int lme = 32 * lb + l31; const float acs_l = __shfl(acs, lme);
                f32x16 ya;
#pragma unroll
                for (int r = 0; r < 16; ++r) ya[r] = 0.f;
#pragma unroll
                for (int k = 0; k < 8; ++k) ya = mfma32(*(const bf16x8*)(CM + (32 * lb + l31) * PW + 16 * k + 8 * hi), *(const bf16x8*)(HB + (32 * pb + l31) * PW + 16 * k + 8 * hi), ya);
#pragma unroll
                for (int r = 0; r < 16; ++r) ya[r] *= fexp(__shfl(acs, 32 * lb + crow(r, hi)));
                for (int hs = 0; hs <= lb; ++hs) {
                    f32x16 st;
#pragma unroll
                    for (int r = 0; r < 16; ++r) st[r] = 0.f;
#pragma unroll
                    for (int k = 0; k < 8; ++k) st = mfma32(*(const bf16x8*)(BMs + (32 * hs + l31) * PW + 16 * k + 8 * hi), *(const bf16x8*)(CM + (32 * lb + l31) * PW + 16 * k + 8 * hi), st);
#pragma unroll
                    for (int r = 0; r < 16; ++r) { const int s = 32 * hs + crow(r, hi); const float as = __shfl(acs, s); st[r] = (s <= lme) ? st[r] * fexp(acs_l - as) : 0.f; }
                    const bf16x8 m0 = pack8(st[0], st[1], st[2], st[3], st[4], st[5], st[6], st[7]), m1 = pack8(st[8], st[9], st[10], st[11], st[12], st[13], st[14], st[15]);
                    const bf16_t* xp = XT + (32 * pb + l31) * PN + 32 * hs + 4 * hi;
                    ya = mfma32(m0, cat8(*(const u32x2*)xp, *(const u32x2*)(xp + 8)), ya);
                    ya = mfma32(m1, cat8(*(const u32x2*)(xp + 16), *(const u32x2*)(xp + 24)), ya);
                }
#pragma unroll
                for (int r = 0; r < 16; ++r) { const int l = 32 * lb + crow(r, hi);
                    if (l < nvalid) { bf16_t* zp = PJ + (rowbase + t0 + l) * NPJ + C_Z + hd * 64 + 32 * pb + l31;
                        const float y = ya[r] + dsk * bf2f(XS[l * PN + 32 * pb + l31]); *zp = (bf16_t)f2bf(y * silu(bf2f(*zp))); } }
            }
        }
        __syncthreads();
#pragma unroll
        for (int r = 0; r < 16; ++r) HB[(32 * ph + crow(r, hi)) * PW + 32 * nq + l31] = (bf16_t)f2bf(Hacc[r]);
    }
    float* so = sample ? P.out() + O_SSSM + ((size_t)(layer * NSB + b) * 32 + hd) * 8192 : P.out() + O_PSSM + ((size_t)(layer * NB + b) * 32 + hd) * 8192;
#pragma unroll
    for (int r = 0; r < 16; ++r) so[(32 * ph + crow(r, hi)) * 128 + 32 * nq + l31] = Hacc[r];
    __syncthreads();
}

__device__ __forceinline__ void set_job(LAS pg8::Job* j_, const bf16_t* A, int lda, const bf16_t* Bt, int ldb, int K, int nM, int nN, void* O, int ldc, int epi, const void* aux, const void* aux2, int auxi) {
    volatile LAS pg8::Job* j = j_;
    j->A = A; j->Bt = Bt; j->O = O; j->aux = aux; j->aux2 = aux2; j->lda = lda; j->ldb = ldb; j->K = K; j->nM = nM; j->nN = nN; j->ldc = ldc; j->epi = epi; j->auxi = auxi;
}

__global__ void __launch_bounds__(512, 2) mega(Params KP) {
    extern __shared__ __attribute__((aligned(16))) unsigned char lds[];
    if (threadIdx.x == 0) { volatile LAS unsigned long long* pd = (volatile LAS unsigned long long*)((LAS unsigned char*)lds + PARAM_OFF);
#pragma unroll
        for (int i = 0; i < 31; ++i) pd[i] = (unsigned long long)KP.in[i];
        pd[31] = (unsigned long long)KP.out; pd[32] = (unsigned long long)KP.ws; }
    __syncthreads();
    PL P; P.base = (const volatile LAS unsigned*)((LAS unsigned char*)lds + PARAM_OFF);
    cg::grid_group grid = cg::this_grid();
    const int tid = threadIdx.x, lane = tid & 63, wave = __builtin_amdgcn_readfirstlane(tid >> 6);
    const int G = gridDim.x, c = blockIdx.x, gw = c * 8 + wave, NGW = G * 8;
    LAS unsigned char* ldsl = (LAS unsigned char*)lds;
    LAS pg8::Job* jt = (LAS pg8::Job*)(ldsl + JT_OFF);
    unsigned char* ws = P.ws();
    bf16_t* PJ = (bf16_t*)(ws + WS_PROJ); bf16_t* XB = (bf16_t*)(ws + WS_XB); bf16_t* VT = XB; bf16_t* WB = (bf16_t*)(ws + WS_W); bf16_t* MPB = (bf16_t*)(ws + WS_MPB);
    float* TAB = (float*)(ws + WS_TAB); float* RSTDQ = (float*)(ws + WS_RSTDQ);
    float* X = P.out() + O_Y;

    if constexpr ((PH & 1) != 0) {
        LAS float* scr = (LAS float*)(ldsl + wave * 16384);
        constexpr int I_IN = 16 * (NPJ / 32), I_OSSM = 32 * 32, I_QB = 8 * 48, I_UK = 4 * 32, I_SQ = 16 * 32;
        constexpr int I_LAYER = I_IN + I_OSSM + I_QB + 2 * I_UK + 5 * I_SQ;
        for (int it = gw; it < I_LAYER * DEPTH; it += NGW) {
            const int layer = it / I_LAYER; int r = it % I_LAYER; bf16_t* wl = WB + (size_t)layer * W_LAYER;
            if (r < I_IN) { const int nb = r % (NPJ / 32), kb = r / (NPJ / 32); transpose_item(P.in(11) + (size_t)layer * 1024 * 11072, 1024, 11072, wl + W_IN, kb, win_src(nb * 32), nb * 32, nullptr, scr, lane); continue; } r -= I_IN;
            if (r < I_OSSM) { transpose_item(P.in(18) + (size_t)layer * 2048 * 1024, 2048, 1024, wl + W_OSSM, r / 32, (r % 32) * 32, (r % 32) * 32, P.in(17) + layer * 2048, scr, lane); continue; } r -= I_OSSM;
            if (r < I_QB) { transpose_item(P.in(20) + (size_t)layer * 512 * 1536, 512, 1536, wl + W_QB, r / 48, (r % 48) * 32, (r % 48) * 32, P.in(19) + layer * 512, scr, lane); continue; } r -= I_QB;
            if (r < I_UK) { transpose_item(P.in(22) + (size_t)layer * 256 * 1024, 256, 1024, wl + W_UK, r / 32, (r % 32) * 32, (r % 32) * 32, nullptr, scr, lane); continue; } r -= I_UK;
            if (r < I_UK) { transpose_item(P.in(23) + (size_t)layer * 256 * 1024, 256, 1024, wl + W_UV, r / 32, (r % 32) * 32, (r % 32) * 32, nullptr, scr, lane); continue; } r -= I_UK;
            const int which = r / I_SQ; r %= I_SQ;
            const float* src = which == 0 ? P.in(24) : which == 1 ? P.in(27) : which == 2 ? P.in(28) : which == 3 ? P.in(25) : P.in(26);
            const size_t dst = which == 0 ? W_OMLA : which == 1 ? W_OMEM : which == 2 ? W_OUT : which == 3 ? W_MK : W_MV;
            transpose_item(src + (size_t)layer * 1024 * 1024, 1024, 1024, wl + dst, r / 32, (r % 32) * 32, (r % 32) * 32, nullptr, scr, lane);
        }
        for (int m = gw; m < MT; m += NGW) { const float* src = m < MP ? P.in(0) + (size_t)m * DM : P.in(1) + (size_t)(m - MP) * DM; ln_row(src, P.in(9), P.in(10), X + (size_t)m * DM, XB + (size_t)m * DM, lane); }
        for (int i = c * 512 + tid; i < 2048 * 1024 / 4; i += G * 512) { const f32x4 v = ((const f32x4*)P.in(2))[i]; u32x2 w; w.x = pk2(v.x, v.y); w.y = pk2(v.z, v.w); ((u32x2*)MPB)[i] = w; }
        for (int i = c * 512 + tid; i < 4128 * 16; i += G * 512) { const int pos = i >> 4, k = i & 15; const float inv = powf(10000.0f, -(float)k / 16.0f); const float ang = (float)pos * inv;
            TAB[2 * i] = cosf(ang); TAB[2 * i + 1] = sinf(ang); }
    }
    grid.sync();

#define OPQ_S(x) asm volatile("" : "+s"(x))
#define OPQ_V(x) asm volatile("" : "+v"(x))
    for (int layer = 0; layer < DEPTH; ++layer) {
        const int tid = opaque_tid(), lane = tid & 63;
        unsigned char* wsl = P.ws(); OPQ_S(wsl);
        bf16_t* PJ = (bf16_t*)(wsl + WS_PROJ); bf16_t* XB = (bf16_t*)(wsl + WS_XB); bf16_t* VT = XB; bf16_t* WB = (bf16_t*)(wsl + WS_W); bf16_t* MPB = (bf16_t*)(wsl + WS_MPB);
        float* TAB = (float*)(wsl + WS_TAB); float* RSTDQ = (float*)(wsl + WS_RSTDQ);
        float* X = P.out() + O_Y;
        bf16_t* wl = WB + (size_t)layer * W_LAYER;
        if constexpr ((PH & 2) != 0) {
            int nj = 0;
            if (tid == 0) {
                OPQ_V(PJ); OPQ_V(wl); OPQ_V(WB); OPQ_V(MPB); OPQ_V(XB);
                if (layer == 0) for (int i = 0; i < DEPTH; ++i) {
                    set_job(jt + nj++, MPB, 1024, WB + (size_t)i * W_LAYER + W_MK, 1024, 1024, 8, 4, P.out() + O_PMK + (size_t)i * 2048 * 1024, 1024, pg8::E_F32, nullptr, nullptr, 0);
                    set_job(jt + nj++, MPB, 1024, WB + (size_t)i * W_LAYER + W_MV, 1024, 1024, 8, 4, P.out() + O_PMV + (size_t)i * 2048 * 1024, 1024, pg8::E_F32, nullptr, nullptr, 0); }
                set_job(jt + nj++, XB, 1024, wl + W_IN, 1024, 1024, MT / 256, NPJ / 256, PJ, NPJ, pg8::E_BF16, nullptr, nullptr, 0);
            }
            __syncthreads();
            pg8::Sched S{jt, layer == 0 ? 9 : 1, 1, G, c};
            pg8::gemm_phase(ldsl, jt, S);
        }
        grid.sync();
        if constexpr ((PH & 4) != 0) {
            for (int u = c; u < 256 + 512; u += G) { const int smp = u >= 256, uu = smp ? u - 256 : u; ssd_unit(P, layer, smp, uu >> 5, uu & 31, lds, tid, wave, lane); }
            for (int m = gw; m < MT; m += NGW) {
                bf16_t* row = PJ + (size_t)m * NPJ;
                const int samp = m >= MP; const int bb = samp ? (m - MP) >> 5 : m >> 12, tt = samp ? (m - MP) & 31 : m & 4095, pos = samp ? PAST + tt : tt;
                { const u32x4 v = *(const u32x4*)(row + C_QA + lane * 8); float s = bflo(v.x) * bflo(v.x) + bfhi(v.x) * bfhi(v.x) + bflo(v.y) * bflo(v.y) + bfhi(v.y) * bfhi(v.y) + bflo(v.z) * bflo(v.z) + bfhi(v.z) * bfhi(v.z) + bflo(v.w) * bflo(v.w) + bfhi(v.w) * bfhi(v.w);
                  s = wave_sum(s); if (lane == 0) RSTDQ[m] = 1.f / sqrtf(s * (1.f / 512.f) + LN_EPS); }
                { const u32x2 v = *(const u32x2*)(row + C_KVA + lane * 4); float a0 = bflo(v.x), a1 = bfhi(v.x), a2 = bflo(v.y), a3 = bfhi(v.y);
                  const float rs = 1.f / sqrtf(wave_sum(a0 * a0 + a1 * a1 + a2 * a2 + a3 * a3) * (1.f / 256.f) + LN_EPS); const f32x4 w = *(const f32x4*)(P.in(21) + layer * 256 + lane * 4);
                  a0 *= rs * w.x; a1 *= rs * w.y; a2 *= rs * w.z; a3 *= rs * w.w;
                  float* op = samp ? P.out() + O_SCKV + ((size_t)(layer * NSB + bb) * DSEQ + tt) * 256 : P.out() + O_PCKV + ((size_t)(layer * NB + bb) * SEQ + tt) * 256;
                  *(f32x4*)(op + lane * 4) = (f32x4){a0, a1, a2, a3}; u32x2 o; o.x = pk2(a0, a1); o.y = pk2(a2, a3); *(u32x2*)(row + C_KVA + lane * 4) = o; }
                { const float x = lane < 32 ? bf2f(row[C_KR + lane]) : 0.f; const float pr = __shfl_xor(x, 16); const int k = lane & 15; const float cs = TAB[((size_t)pos * 16 + k) * 2], sn = TAB[((size_t)pos * 16 + k) * 2 + 1];
                  const float o = (lane & 16) ? x * cs + pr * sn : x * cs - pr * sn;
                  if (lane < 32) { float* op = samp ? P.out() + O_SKR + ((size_t)(layer * NSB + bb) * DSEQ + tt) * 32 : P.out() + O_PKR + ((size_t)(layer * NB + bb) * SEQ + tt) * 32; op[lane] = o; row[C_KR + lane] = (bf16_t)f2bf(o); } }
            }
        }
        grid.sync();
        if constexpr ((PH & 8) != 0) {
            for (int m = gw; m < MT; m += NGW) {
                bf16_t* row = PJ + (size_t)m * NPJ + C_Z + lane * 32; u32x4 v[4]; float s = 0.f;
#pragma unroll
                for (int j = 0; j < 4; ++j) { v[j] = *(const u32x4*)(row + 8 * j); s += bflo(v[j].x) * bflo(v[j].x) + bfhi(v[j].x) * bfhi(v[j].x) + bflo(v[j].y) * bflo(v[j].y) + bfhi(v[j].y) * bfhi(v[j].y) + bflo(v[j].z) * bflo(v[j].z) + bfhi(v[j].z) * bfhi(v[j].z) + bflo(v[j].w) * bflo(v[j].w) + bfhi(v[j].w) * bfhi(v[j].w); }
                s += __shfl_xor(s, 1); s += __shfl_xor(s, 2); s += __shfl_xor(s, 4); s += __shfl_xor(s, 8);
                const float rs = 1.f / sqrtf(s * (1.f / 512.f) + LN_EPS);
#pragma unroll
                for (int j = 0; j < 4; ++j) { u32x4 o; o.x = pk2(bflo(v[j].x) * rs, bfhi(v[j].x) * rs); o.y = pk2(bflo(v[j].y) * rs, bfhi(v[j].y) * rs); o.z = pk2(bflo(v[j].z) * rs, bfhi(v[j].z) * rs); o.w = pk2(bflo(v[j].w) * rs, bfhi(v[j].w) * rs); *(u32x4*)(row + 8 * j) = o; }
            }
            if (tid == 0) {
                OPQ_V(PJ); OPQ_V(wl); OPQ_V(VT); OPQ_V(RSTDQ); OPQ_V(TAB);
                set_job(jt + 0, PJ + C_QA, NPJ, wl + W_QB, 512, 512, MT / 256, 6, PJ + C_Q, NPJ, pg8::E_QROPE, RSTDQ, TAB, 0);
                set_job(jt + 1, PJ + C_KVA, NPJ, wl + W_UK, 256, 256, MP / 256, 4, PJ + C_KN, NPJ, pg8::E_BF16, nullptr, nullptr, 0);
                set_job(jt + 2, wl + W_UV, 256, PJ + C_KVA, NPJ, 256, 4, MP / 256, VT, MP, pg8::E_BF16, nullptr, nullptr, 0);
            }
            __syncthreads();
            pg8::Sched S{jt, 3, 1, G, c};
            pg8::gemm_phase(ldsl, jt, S);
        }
        grid.sync();
        if constexpr ((PH & 16) != 0) {
            for (int u = c; u < 256; u += G) if (wave == ((u / G) & 7)) mla_sample_wave(P, PJ, wl + W_UV, layer, u >> 4, u & 15, lane);
            for (int pi = c; pi < 1024; pi += G) { const int bh = pi >> 3, s = pi & 7;
                for (int k = 0; k < 2; ++k) { const int qb = k ? 15 - s : s; mla_prompt_wave(PJ, VT, bh >> 4, bh & 15, qb * 256 + wave * 32, lane); } }
            for (int u = gw; u < (MT / 32) * 4; u += NGW) { const int rb = u >> 2, h = u & 3, r0 = rb * 32;
                const float* KB; const float* VB;
                if (r0 < MP) { const int bb = r0 >> 12; KB = P.out() + O_PMK + ((size_t)layer * NB + bb) * 256 * 1024; VB = P.out() + O_PMV + ((size_t)layer * NB + bb) * 256 * 1024; }
                else { const int bb = (r0 - MP) >> 5; KB = P.in(7) + ((size_t)layer * NSB + bb) * 256 * 1024; VB = P.in(8) + ((size_t)layer * NSB + bb) * 256 * 1024; }
                mem_attn_wave(PJ, KB, VB, r0, h, lane); }
        }
        grid.sync();
        if constexpr ((PH & 32) != 0) {
            if (tid == 0) {
                OPQ_V(PJ); OPQ_V(wl);
                set_job(jt + 0, PJ + C_Z, NPJ, wl + W_OSSM, 2048, 2048, MT / 256, 4, PJ + C_H, NPJ, pg8::E_MERGE, PJ + C_GT, nullptr, 0);
                set_job(jt + 1, PJ + C_GM, NPJ, wl + W_OMLA, 1024, 1024, MT / 256, 4, PJ + C_H, NPJ, pg8::E_MERGE, PJ + C_GT + 1024, nullptr, 1);
                set_job(jt + 2, PJ + C_QM, NPJ, wl + W_OMEM, 1024, 1024, MT / 256, 4, PJ + C_H, NPJ, pg8::E_MERGE, PJ + C_GT + 2048, nullptr, 2);
            }
            __syncthreads();
            pg8::Sched S{jt, 3, 3, G, c};
            pg8::gemm_phase(ldsl, jt, S);
        }
        grid.sync();
        if constexpr ((PH & 64) != 0) {
            if (tid == 0) { OPQ_V(PJ); OPQ_V(wl); OPQ_V(X); set_job(jt + 0, PJ + C_H, NPJ, wl + W_OUT, 1024, 1024, MT / 256, 4, X, 1024, pg8::E_OUT, nullptr, nullptr, 0); }
            __syncthreads();
            pg8::Sched S{jt, 1, 1, G, c};
            pg8::gemm_phase(ldsl, jt, S);
        }
        grid.sync();
        for (int m = gw; m < MT; m += NGW) ln_row(X + (size_t)m * DM, P.in(29) + layer * DM, P.in(30) + layer * DM, X + (size_t)m * DM, XB + (size_t)m * DM, lane);
        if (layer + 1 < DEPTH) grid.sync();
    }
}

extern "C" void kernel_launch(void* const* d_in, const int* in_sizes, int n_in, void* d_out, int out_size, void* d_ws, size_t ws_size, hipStream_t stream) {
    static int grid = 0;
    if (grid == 0) {
        int dev = 0, cus = 0, per_cu = 0;
        (void)hipGetDevice(&dev);
        (void)hipDeviceGetAttribute(&cus, hipDeviceAttributeMultiprocessorCount, dev);
        (void)hipFuncSetAttribute((const void*)mega, hipFuncAttributeMaxDynamicSharedMemorySize, LDS_BYTES);
        (void)hipOccupancyMaxActiveBlocksPerMultiprocessor(&per_cu, (const void*)mega, 512, LDS_BYTES);
        if (per_cu < 1) per_cu = 1;
        grid = cus * per_cu;
        if (grid % 8) grid -= grid % 8;
        fprintf(stderr, "grid %d (cus %d per_cu %d) ws %zu need %zu\n", grid, cus, per_cu, ws_size, (size_t)WS_END);
        if (ws_size < WS_END || n_in != 31) { fprintf(stderr, "workspace too small or bad inputs\n"); grid = -1; }
    }
    if (grid < 0) return;
    Params p{};
    for (int i = 0; i < 31; ++i) p.in[i] = (const float*)d_in[i];
    p.out = (float*)d_out; p.ws = (unsigned char*)d_ws;
    void* args[] = {&p};
    hipError_t e = hipLaunchCooperativeKernel((const void*)mega, dim3(grid), dim3(512), args, LDS_BYTES, stream);
    if (e != hipSuccess) fprintf(stderr, "coop launch failed: %s\n", hipGetErrorString(e));
}
```

```cpp
#include <hip/hip_runtime.h>
#include <hip/hip_cooperative_groups.h>
#include <cstdio>
#include <cstdint>
namespace cg = cooperative_groups;

#define LAS __attribute__((address_space(3)))
typedef unsigned short bf16_t;
typedef short bf16x8 __attribute__((ext_vector_type(8)));
typedef float f32x4 __attribute__((ext_vector_type(4)));
typedef float f32x16 __attribute__((ext_vector_type(16)));
typedef unsigned u32x4 __attribute__((ext_vector_type(4)));
typedef unsigned u32x2 __attribute__((ext_vector_type(2)));

constexpr int DM = 1024, MP = 32768, MS = 512, MT = MP + MS, SEQ = 4096, NB = 8, NSB = 16, DSEQ = 32, PAST = 4096, DEPTH = 4;
constexpr int NPJ = 11264;
constexpr int C_Z = 0, C_XBC = 2048, C_QA = 5120, C_KVA = 5632, C_GM = 5888, C_QM = 6912, C_GT = 7936, C_DT = 11008, C_KR = 11040;
constexpr int C_Q = 2048, C_KN = 3584, C_H = 2048;
constexpr float LN_EPS = 1e-5f;
constexpr float ALPHA = 1.681792830507429f;
constexpr float LOG2E = 1.4426950408889634f;
constexpr float MLA_SC = 0.10206207261596575f * LOG2E;
constexpr float MEM_SC = 0.0625f * LOG2E;
constexpr long O_Y = 0;
constexpr long O_PSSM = (long)MT * DM;
constexpr long O_PCONV = O_PSSM + 4L * 8 * 32 * 64 * 128;
constexpr long O_PCKV = O_PCONV + 4L * 8 * 3 * 3072;
constexpr long O_PKR = O_PCKV + 4L * 8 * 4096 * 256;
constexpr long O_PMK = O_PKR + 4L * 8 * 4096 * 32;
constexpr long O_PMV = O_PMK + 4L * 8 * 256 * 1024;
constexpr long O_SSSM = O_PMV + 4L * 8 * 256 * 1024;
constexpr long O_SCONV = O_SSSM + 4L * 16 * 32 * 64 * 128;
constexpr long O_SCKV = O_SCONV + 4L * 16 * 3 * 3072;
constexpr long O_SKR = O_SCKV + 4L * 16 * 32 * 256;
constexpr size_t WS_PROJ = 0;
constexpr size_t WS_XB = WS_PROJ + (size_t)MT * NPJ * 2;
constexpr size_t WS_W = WS_XB + (size_t)MT * DM * 2;
constexpr size_t W_IN = 0, W_OSSM = W_IN + (size_t)NPJ * 1024, W_QB = W_OSSM + 1024 * 2048, W_UK = W_QB + 1536 * 512, W_UV = W_UK + 1024 * 256,
                 W_OMLA = W_UV + 1024 * 256, W_OMEM = W_OMLA + 1024 * 1024, W_OUT = W_OMEM + 1024 * 1024, W_MK = W_OUT + 1024 * 1024, W_MV = W_MK + 1024 * 1024,
                 W_LAYER = W_MV + 1024 * 1024;
constexpr size_t WS_MPB = WS_W + W_LAYER * 2 * DEPTH;
constexpr size_t WS_TAB = WS_MPB + (size_t)2048 * 1024 * 2;
constexpr size_t WS_RSTDQ = WS_TAB + (size_t)4128 * 32 * 4;
constexpr size_t WS_PART = WS_RSTDQ + (size_t)MT * 4;
constexpr size_t WS_JT = WS_PART + (size_t)16 * 8 * 16 * 2 * 34 * 64 * 4;
constexpr size_t WS_END = WS_JT + 16384;

#ifndef PH
#define PH 0xffff
#endif
#ifndef PROBE
#define PROBE 0
#endif
constexpr int RING_BYTES = 131072, JT_OFF = RING_BYTES, LDS_BYTES = 147456;

struct Params { const float* in[31]; float* out; unsigned char* ws; };
constexpr int PARAM_OFF = 131072 + 1024;
struct PL {
    const volatile LAS unsigned* base;
    __device__ __forceinline__ unsigned long long ldp(int i) const {
        unsigned a = (unsigned)(uintptr_t)base + 8u * (unsigned)i; asm volatile("" : "+s"(a));
        const volatile LAS unsigned* p = (const volatile LAS unsigned*)(uintptr_t)a;
        const unsigned lo = __builtin_amdgcn_readfirstlane(p[0]), hi = __builtin_amdgcn_readfirstlane(p[1]); return ((unsigned long long)hi << 32) | lo; }
    __device__ __forceinline__ const float* in(int i) const { return (const float*)ldp(i); }
    __device__ __forceinline__ float* out() const { return (float*)ldp(31); }
    __device__ __forceinline__ unsigned char* ws() const { return (unsigned char*)ldp(32); }
};

__device__ __forceinline__ unsigned f2bf(float f) { unsigned u = __builtin_bit_cast(unsigned, f); return (u + 0x7fffu + ((u >> 16) & 1u)) >> 16; }
__device__ __forceinline__ unsigned pk2(float lo, float hi) { typedef float f2_ __attribute__((ext_vector_type(2))); typedef __bf16 b2_ __attribute__((ext_vector_type(2))); f2_ v = {lo, hi}; b2_ b = __builtin_convertvector(v, b2_); return __builtin_bit_cast(unsigned, b); }
__device__ __forceinline__ float bf2f(unsigned h) { return __builtin_bit_cast(float, h << 16); }
__device__ __forceinline__ float bflo(unsigned w) { return __builtin_bit_cast(float, w << 16); }
__device__ __forceinline__ float bfhi(unsigned w) { return __builtin_bit_cast(float, w & 0xffff0000u); }
__device__ __forceinline__ float ex2(float x) { return __builtin_amdgcn_exp2f(x); }
__device__ __forceinline__ float fexp(float x) { return __builtin_amdgcn_exp2f(x * LOG2E); }
__device__ __forceinline__ float sigm(float x) { return 1.0f / (1.0f + fexp(-x)); }
__device__ __forceinline__ float silu(float x) { return x * sigm(x); }
__device__ __forceinline__ bf16x8 pack8(float a, float b, float c, float d, float e, float f, float g, float h) {
    u32x4 w; w.x = pk2(a, b); w.y = pk2(c, d); w.z = pk2(e, f); w.w = pk2(g, h); return __builtin_bit_cast(bf16x8, w);
}
__device__ __forceinline__ bf16x8 pack8v(f32x4 a, f32x4 b) { return pack8(a.x, a.y, a.z, a.w, b.x, b.y, b.z, b.w); }
__device__ __forceinline__ bf16x8 cat8(u32x2 a, u32x2 b) { u32x4 w; w.x = a.x; w.y = a.y; w.z = b.x; w.w = b.y; return __builtin_bit_cast(bf16x8, w); }
__device__ __forceinline__ int crow(int r, int hi) { return (r & 3) + 8 * (r >> 2) + 4 * hi; }
__device__ __forceinline__ float wave_sum(float v) {
#pragma unroll
    for (int o = 1; o < 64; o <<= 1) v += __shfl_xor(v, o);
    return v;
}
__device__ __forceinline__ int opaque_tid() { int t = threadIdx.x; asm volatile("" : "+v"(t)); return t; }
__device__ __forceinline__ f32x16 mfma32(bf16x8 a, bf16x8 b, f32x16 c) { return __builtin_amdgcn_mfma_f32_32x32x16_bf16(a, b, c, 0, 0, 0); }

namespace pg8 {
constexpr int BM = 256, BK = 64, HALF = 128, HTB = HALF * BK * 2;
__device__ __forceinline__ int lds_byte(int r, int c) { const int st = (r >> 4) * 2 + (c >> 5), rr = r & 15, cc = c & 31, ob = rr * 64 + cc * 2; return st * 1024 + (ob ^ (((ob >> 9) & 1) << 5)); }
__device__ __forceinline__ void stage_rc(int b, int& R, int& C) { const int st = b / 1024, sb = b % 1024, swz = sb ^ (((sb >> 9) & 1) << 5); R = (st >> 1) * 16 + swz / 64; C = (st & 1) * 32 + (swz % 64) / 2; }
__device__ __forceinline__ int perm32(int rho) { const int n = rho >> 4, i = rho & 15; return 8 * (i >> 2) + 4 * n + (i & 3); }

enum { E_BF16 = 0, E_F32 = 1, E_QROPE = 2, E_MERGE = 3, E_OUT = 4 };
struct Job { const bf16_t* A; const bf16_t* Bt; void* O; const void* aux; const void* aux2; int lda, ldb, K, nM, nN, ldc, epi, auxi; };
struct Unit { int job, pm, pn; };

struct Sched {
    const LAS Job* jt; int nj, sub, G, c;
    __device__ __forceinline__ bool next(int i, Unit& u) const {
        int L, j = 0;
        if (sub > 1) { j = i % sub; L = (i / sub) * G + c; if (L >= jt[0].nM * jt[0].nN) return false; }
        else { L = i * G + c; for (;;) { if (j >= nj) return false; const int n = jt[j].nM * jt[j].nN; if (L < n) break; L -= n; ++j; } }
        const int nM = jt[j].nM, nN = jt[j].nN, nwg = nM * nN;
        int wgid = L; { const int q = nwg / 8, r = nwg % 8, xcd = wgid % 8, off = wgid / 8; wgid = (xcd < r ? xcd * (q + 1) : r * (q + 1) + (xcd - r) * q) + off; }
        const int nig = 8 * nN, gid = wgid / nig, fm = gid * 8, gsz = (nM - fm) < 8 ? (nM - fm) : 8;
        u.pm = __builtin_amdgcn_readfirstlane(fm + ((wgid % nig) % gsz)); u.pn = __builtin_amdgcn_readfirstlane((wgid % nig) / gsz); u.job = __builtin_amdgcn_readfirstlane(j); return true;
    }
};

__device__ __forceinline__ unsigned cvt_pk_bf16(float lo, float hi) { unsigned r; asm volatile("v_cvt_pk_bf16_f32 %0, %1, %2" : "=v"(r) : "v"(lo), "v"(hi)); return r; }

__device__ __forceinline__ void epilogue(const f32x4 (&acc)[2][2][4][2], const LAS Job* jb, const Unit& u, int wr, int wc, int fr, int fq, int dry) {
    if (dry) return;
    const int epi = jb->epi, ldc = jb->ldc;
    const int row0 = u.pm * BM + wr * 64 + fr, col0 = u.pn * BM + wc * 32 + 8 * fq;
    if (epi == E_BF16) {
        bf16_t* O = (bf16_t*)jb->O;
#pragma unroll
        for (int ai = 0; ai < 2; ++ai)
#pragma unroll
            for (int m = 0; m < 4; ++m) { bf16_t* rowp = O + (size_t)(row0 + ai * HALF + m * 16) * ldc + col0;
#pragma unroll
                for (int bj = 0; bj < 2; ++bj) { const f32x4 v0 = acc[ai][bj][m][0], v1 = acc[ai][bj][m][1]; u32x4 w; w.x = cvt_pk_bf16(v0[0], v0[1]); w.y = cvt_pk_bf16(v0[2], v0[3]); w.z = cvt_pk_bf16(v1[0], v1[1]); w.w = cvt_pk_bf16(v1[2], v1[3]);
                    *(u32x4*)(rowp + bj * HALF) = w; } }
    } else if (epi == E_F32) {
        float* O = (float*)jb->O;
#pragma unroll
        for (int ai = 0; ai < 2; ++ai)
#pragma unroll
            for (int m = 0; m < 4; ++m) { float* rowp = O + (size_t)(row0 + ai * HALF + m * 16) * ldc + col0;
#pragma unroll
                for (int bj = 0; bj < 2; ++bj) { *(f32x4*)(rowp + bj * HALF) = acc[ai][bj][m][0]; *(f32x4*)(rowp + bj * HALF + 4) = acc[ai][bj][m][1]; } }
    } else if (epi == E_OUT) {
        float* O = (float*)jb->O;
#pragma unroll
        for (int ai = 0; ai < 2; ++ai)
#pragma unroll
            for (int m = 0; m < 4; ++m) { float* rowp = O + (size_t)(row0 + ai * HALF + m * 16) * ldc + col0;
#pragma unroll
                for (int bj = 0; bj < 2; ++bj) { const f32x4 x0 = *(const f32x4*)(rowp + bj * HALF), x1 = *(const f32x4*)(rowp + bj * HALF + 4);
                    *(f32x4*)(rowp + bj * HALF) = x0 * ALPHA + acc[ai][bj][m][0]; *(f32x4*)(rowp + bj * HALF + 4) = x1 * ALPHA + acc[ai][bj][m][1]; }
                asm volatile("" ::: "memory"); }
    } else if (epi == E_MERGE) {
        bf16_t* O = (bf16_t*)jb->O; const bf16_t* G = (const bf16_t*)jb->aux; const int first = (jb->auxi == 0);
#pragma unroll
        for (int ai = 0; ai < 2; ++ai)
#pragma unroll
            for (int m = 0; m < 4; ++m) { const size_t ro = (size_t)(row0 + ai * HALF + m * 16) * ldc + col0;
#pragma unroll
                for (int bj = 0; bj < 2; ++bj) { const u32x4 g = *(const u32x4*)(G + ro + bj * HALF); u32x4 h = (u32x4){0u, 0u, 0u, 0u}; if (!first) h = *(const u32x4*)(O + ro + bj * HALF);
                    const f32x4 v0 = acc[ai][bj][m][0], v1 = acc[ai][bj][m][1]; u32x4 w;
                    w.x = pk2(bflo(h.x) + sigm(bflo(g.x)) * v0[0], bfhi(h.x) + sigm(bfhi(g.x)) * v0[1]);
                    w.y = pk2(bflo(h.y) + sigm(bflo(g.y)) * v0[2], bfhi(h.y) + sigm(bfhi(g.y)) * v0[3]);
                    w.z = pk2(bflo(h.z) + sigm(bflo(g.z)) * v1[0], bfhi(h.z) + sigm(bfhi(g.z)) * v1[1]);
                    w.w = pk2(bflo(h.w) + sigm(bflo(g.w)) * v1[2], bfhi(h.w) + sigm(bfhi(g.w)) * v1[3]);
                    *(u32x4*)(O + ro + bj * HALF) = w; }
                asm volatile("" ::: "memory"); }
    } else {
        bf16_t* O = (bf16_t*)jb->O; const float* RS = (const float*)jb->aux; const float* TAB = (const float*)jb->aux2;
#pragma unroll
        for (int ai = 0; ai < 2; ++ai)
#pragma unroll
            for (int m = 0; m < 4; ++m) { const int row = row0 + ai * HALF + m * 16; const float rs = RS[row];
                const int pos = row < MP ? (row & (SEQ - 1)) : PAST + ((row - MP) & (DSEQ - 1));
#pragma unroll
                for (int bj = 0; bj < 2; ++bj) { const int gc = col0 + bj * HALF; f32x4 v0 = acc[ai][bj][m][0] * rs, v1 = acc[ai][bj][m][1] * rs;
                    if (((gc >> 5) % 3) == 2) {
                        const float* tp = TAB + ((size_t)pos * 16 + 8 * (fq & 1)) * 2; const f32x4 t0 = *(const f32x4*)tp, t1 = *(const f32x4*)(tp + 4), t2 = *(const f32x4*)(tp + 8), t3 = *(const f32x4*)(tp + 12);
                        f32x4 p0, p1;
#pragma unroll
                        for (int e = 0; e < 4; ++e) { p0[e] = __shfl_xor(v0[e], 32); p1[e] = __shfl_xor(v1[e], 32); }
                        const float sg = (fq >> 1) ? 1.f : -1.f;
                        v0 = (f32x4){v0[0] * t0[0] + sg * p0[0] * t0[1], v0[1] * t0[2] + sg * p0[1] * t0[3], v0[2] * t1[0] + sg * p0[2] * t1[1], v0[3] * t1[2] + sg * p0[3] * t1[3]};
                        v1 = (f32x4){v1[0] * t2[0] + sg * p1[0] * t2[1], v1[1] * t2[2] + sg * p1[1] * t2[3], v1[2] * t3[0] + sg * p1[2] * t3[1], v1[3] * t3[2] + sg * p1[3] * t3[3]};
                    }
                    u32x4 w; w.x = pk2(v0[0], v0[1]); w.y = pk2(v0[2], v0[3]); w.z = pk2(v1[0], v1[1]); w.w = pk2(v1[2], v1[3]);
                    *(u32x4*)(O + (size_t)row * ldc + gc) = w; }
                asm volatile("" ::: "memory"); }
    }
}

struct UP { const char* A; const char* B; unsigned la2, lb2; int nt; };
__device__ __forceinline__ void load_up(UP& p, const LAS Job* jt, const Unit& u) {
    const LAS Job* jb = jt + u.job; const int lda = __builtin_amdgcn_readfirstlane(jb->lda), ldb = __builtin_amdgcn_readfirstlane(jb->ldb);
    p.A = (const char*)jb->A + (size_t)u.pm * 256 * lda * 2; p.B = (const char*)jb->Bt + (size_t)u.pn * 256 * ldb * 2;
    p.la2 = (unsigned)(lda * 2); p.lb2 = (unsigned)(ldb * 2);
    p.nt = __builtin_amdgcn_readfirstlane(jb->K / BK);
}

__device__ __forceinline__ void gemm_phase(LAS unsigned char* lds, const LAS Job* jt, const Sched& S, int dry = 0) {
    const int tid = opaque_tid(), wid = __builtin_amdgcn_readfirstlane(tid >> 6), lane = tid & 63, wr = wid >> 2, wc = wid & 3, fr = lane & 15, fq = lane >> 4;
    int R0, C0; stage_rc(tid * 16, R0, C0); const int Rb0 = (R0 & ~31) + perm32(R0 & 31); const unsigned C2 = (unsigned)C0 * 2u;
    const size_t kstep = (size_t)(BK * 2);
    const unsigned ldsw = (unsigned)wid * 1024u;
    const int aoff = lds_byte(wr * 64 + fr, fq * 8), boff = lds_byte(wc * 32 + fr, fq * 8);
#define PG8_SA(b, h) (((b) * 2 + (h)) * HTB)
#define PG8_SB(b, h) ((4 + (b) * 2 + (h)) * HTB)
#define PG8_STAGE(bufoff, gbase, RR, ld2) do { const unsigned v_ = (unsigned)(RR) * (ld2) + C2; \
        __builtin_amdgcn_global_load_lds((const unsigned*)((const char*)(gbase) + v_), (LAS unsigned*)(lds + (bufoff) + ldsw), 16, 0, 0); \
        __builtin_amdgcn_global_load_lds((const unsigned*)((const char*)(gbase) + 64u * (ld2) + v_), (LAS unsigned*)(lds + (bufoff) + ldsw + 8192), 16, 0, 0); } while (0)
#define PG8_LDA(dst, b, h) do { _Pragma("unroll") for (int m = 0; m < 4; ++m) _Pragma("unroll") for (int k = 0; k < 2; ++k) dst[m][k] = *(const LAS bf16x8*)(lds + PG8_SA(b, h) + aoff + m * 2048 + k * 1024); } while (0)
#define PG8_LDB(dst, b, h) do { _Pragma("unroll") for (int n = 0; n < 2; ++n) _Pragma("unroll") for (int k = 0; k < 2; ++k) dst[n][k] = *(const LAS bf16x8*)(lds + PG8_SB(b, h) + boff + n * 2048 + k * 1024); } while (0)
#define PG8_MMA(ai, bj, At, Bt) do { __builtin_amdgcn_s_setprio(1); _Pragma("unroll") for (int m = 0; m < 4; ++m) _Pragma("unroll") for (int n = 0; n < 2; ++n) _Pragma("unroll") for (int k = 0; k < 2; ++k) \
        acc[ai][bj][m][n] = __builtin_amdgcn_mfma_f32_16x16x32_bf16(Bt[n][k], At[m][k], acc[ai][bj][m][n], 0, 0, 0); __builtin_amdgcn_s_setprio(0); } while (0)
#define PG8_WAIT_V(n) asm volatile("s_waitcnt vmcnt(" #n ")" ::: "memory")
#define PG8_WAIT_L(n) asm volatile("s_waitcnt lgkmcnt(" #n ")" ::: "memory")
#define PG8_BAR __builtin_amdgcn_s_barrier()
#define PG8_SCHED __builtin_amdgcn_sched_barrier(0)
    Unit cur, nxt; int ui = 0;
    if (!S.next(0, cur)) return;
    UP pc, pn; load_up(pc, jt, cur);
    f32x4 acc[2][2][4][2];
#pragma unroll
    for (int a = 0; a < 2; ++a)
#pragma unroll
        for (int b = 0; b < 2; ++b)
#pragma unroll
            for (int m = 0; m < 4; ++m)
#pragma unroll
                for (int n = 0; n < 2; ++n) acc[a][b][m][n] = (f32x4){0.f, 0.f, 0.f, 0.f};
    bf16x8 At[4][2], B0[2][2], B1[2][2];
    {
        const char* cA = pc.A; const char* cB = pc.B;
        PG8_STAGE(PG8_SB(0, 0), cB, Rb0, pc.lb2); PG8_STAGE(PG8_SB(0, 1), cB + 128u * pc.lb2, Rb0, pc.lb2); PG8_STAGE(PG8_SA(0, 0), cA, R0, pc.la2); PG8_STAGE(PG8_SA(0, 1), cA + 128u * pc.la2, R0, pc.la2);
        if (wr == 1) PG8_BAR;
        PG8_WAIT_V(2); PG8_BAR;
        PG8_STAGE(PG8_SB(1, 0), cB + kstep, Rb0, pc.lb2); PG8_STAGE(PG8_SA(1, 0), cA + kstep, R0, pc.la2); PG8_STAGE(PG8_SB(1, 1), cB + 128u * pc.lb2 + kstep, Rb0, pc.lb2);
        PG8_WAIT_V(6); PG8_BAR;
    }
    for (;;) {
        const bool has_next = S.next(ui + 1, nxt);
        if (has_next) load_up(pn, jt, nxt); else pn = pc;
        const char* cA = pc.A; const char* cB = pc.B; const int nt = pc.nt;
        for (int t = 0; t < nt; t += 2) {
            const bool last = (t == nt - 2);
            const char* a1 = cA + (size_t)(t + 1) * kstep;
            const char* a2 = last ? pn.A : cA + (size_t)(t + 2) * kstep; const char* b2 = last ? pn.B : cB + (size_t)(t + 2) * kstep;
            const char* a3 = a2 + kstep; const char* b3 = b2 + kstep;
            const unsigned la2 = last ? pn.la2 : pc.la2, lb2 = last ? pn.lb2 : pc.lb2;
            PG8_LDB(B0, 0, 0); PG8_LDB(B1, 0, 1); PG8_SCHED; PG8_LDA(At, 0, 0); PG8_STAGE(PG8_SA(1, 1), a1 + 128u * pc.la2, R0, pc.la2);
            PG8_WAIT_V(8); PG8_WAIT_L(0); PG8_BAR; PG8_MMA(0, 0, At, B0); PG8_MMA(0, 1, At, B1); PG8_BAR; PG8_SCHED;
            PG8_LDA(At, 0, 1); PG8_STAGE(PG8_SB(0, 0), b2, Rb0, lb2); PG8_STAGE(PG8_SB(0, 1), b2 + 128u * lb2, Rb0, lb2); PG8_STAGE(PG8_SA(0, 0), a2, R0, la2);
            PG8_WAIT_V(8); PG8_WAIT_L(0); PG8_BAR; PG8_MMA(1, 0, At, B0); PG8_MMA(1, 1, At, B1); PG8_BAR; PG8_SCHED;
            PG8_LDB(B0, 1, 0); PG8_LDB(B1, 1, 1); PG8_SCHED; PG8_LDA(At, 1, 0); PG8_STAGE(PG8_SA(0, 1), a2 + 128u * la2, R0, la2);
            PG8_WAIT_V(8); PG8_WAIT_L(0); PG8_BAR; PG8_MMA(0, 0, At, B0); PG8_MMA(0, 1, At, B1); PG8_BAR; PG8_SCHED;
            PG8_LDA(At, 1, 1); PG8_STAGE(PG8_SB(1, 0), b3, Rb0, lb2); PG8_STAGE(PG8_SB(1, 1), b3 + 128u * lb2, Rb0, lb2); PG8_STAGE(PG8_SA(1, 0), a3, R0, la2);
            PG8_WAIT_V(8); PG8_WAIT_L(0); PG8_BAR; PG8_MMA(1, 0, At, B0); PG8_MMA(1, 1, At, B1); PG8_BAR; PG8_SCHED;
        }
        if (wr == 0) PG8_BAR;
        epilogue(acc, jt + cur.job, cur, wr, wc, fr, fq, dry);
        if (!has_next) break;
#pragma unroll
        for (int a = 0; a < 2; ++a)
#pragma unroll
            for (int b = 0; b < 2; ++b)
#pragma unroll
                for (int m = 0; m < 4; ++m)
#pragma unroll
                    for (int n = 0; n < 2; ++n) acc[a][b][m][n] = (f32x4){0.f, 0.f, 0.f, 0.f};
        cur = nxt; pc = pn; ++ui;
        if (wr == 1) PG8_BAR;
    }
    PG8_WAIT_V(0);
    PG8_BAR;
#undef PG8_SA
#undef PG8_SB
#undef PG8_STAGE
#undef PG8_LDA
#undef PG8_LDB
#undef PG8_MMA
#undef PG8_WAIT_V
#undef PG8_WAIT_L
#undef PG8_BAR
#undef PG8_SCHED
}
}

__device__ __forceinline__ void transpose_item(const float* W, int K, int N, bf16_t* WT, int kb, int ns, int nd, const float* sk, LAS float* scr, int lane) {
    const int k0 = 64 * kb;
#pragma unroll 8
    for (int i = 0; i < 32; ++i) { const int kk = 2 * i + (lane >> 5); float v = 0.f; if (ns >= 0) { v = W[(size_t)(k0 + kk) * N + ns + (lane & 31)]; if (sk) v *= sk[k0 + kk]; } scr[kk * 33 + (lane & 31)] = v; }
    asm volatile("s_waitcnt lgkmcnt(0)" ::: "memory");
    const int c = lane & 7;
#pragma unroll
    for (int j = 0; j < 4; ++j) { const int n = (lane >> 3) + 8 * j; const LAS float* s = scr + (8 * c) * 33 + n;
        u32x4 o; o.x = pk2(s[0 * 33], s[1 * 33]); o.y = pk2(s[2 * 33], s[3 * 33]); o.z = pk2(s[4 * 33], s[5 * 33]); o.w = pk2(s[6 * 33], s[7 * 33]);
        *(u32x4*)(WT + (size_t)(nd + n) * K + k0 + 8 * c) = o; }
    asm volatile("s_waitcnt lgkmcnt(0)" ::: "memory");
}
__device__ __forceinline__ int win_src(int n) {
    if (n < 5120) return n;
    if (n < 5632) return n - 5120 + 5152;
    if (n < 5888) return n - 5632 + 5664;
    if (n < 6912) return n - 5888 + 5952;
    if (n < 7936) return n - 6912 + 6976;
    if (n < 11008) return n - 7936 + 8000;
    if (n < 11040) return n - 11008 + 5120;
    if (n < 11072) return n - 11040 + 5920;
    return -1;
}
__device__ __forceinline__ void ln_row(const float* src, const float* g, const float* b, float* dstf, bf16_t* dstb, int lane, int dry = 0) {
    const f32x4* xr = (const f32x4*)src + lane; f32x4 v[4]; float s = 0.f;
#pragma unroll
    for (int j = 0; j < 4; ++j) { v[j] = xr[64 * j]; s += (v[j].x + v[j].y) + (v[j].z + v[j].w); }
    const float mean = wave_sum(s) * (1.f / DM); float s2 = 0.f;
#pragma unroll
    for (int j = 0; j < 4; ++j) { v[j] = v[j] - mean; s2 += (v[j].x * v[j].x + v[j].y * v[j].y) + (v[j].z * v[j].z + v[j].w * v[j].w); }
    const float rstd = 1.f / sqrtf(wave_sum(s2) * (1.f / DM) + LN_EPS);
#pragma unroll
    for (int j = 0; j < 4; ++j) { const f32x4 gg = ((const f32x4*)g)[lane + 64 * j], bb = ((const f32x4*)b)[lane + 64 * j]; const f32x4 o = v[j] * rstd * gg + bb;
        u32x2 w; w.x = pk2(o.x, o.y); w.y = pk2(o.z, o.w); if (!dry) { ((f32x4*)dstf)[lane + 64 * j] = o; ((u32x2*)dstb)[lane + 64 * j] = w; } }
}

template <int KS, int DVB, class KL, class VL>
__device__ __forceinline__ void attn_half(f32x16 (&o)[DVB], float& mrun, float& lrun, const bf16x8 (&q)[KS], float sc, KL kl, VL vl) {
    f32x16 st;
#pragma unroll
    for (int r = 0; r < 16; ++r) st[r] = 0.f;
#pragma unroll
    for (int s = 0; s < KS; ++s) st = mfma32(kl(s), q[s], st);
    float mx = st[0];
#pragma unroll
    for (int r = 1; r < 16; ++r) mx = fmaxf(mx, st[r]);
    mx = fmaxf(mx, __shfl_xor(mx, 32));
    const float mnew = fmaxf(mrun, mx);
    const float alpha = ex2((mrun - mnew) * sc);
    const float mb = mnew * sc; float ps = 0.f;
#pragma unroll
    for (int r = 0; r < 16; ++r) { st[r] = ex2(st[r] * sc - mb); ps += st[r]; }
    lrun = lrun * alpha + ps;
    if (__any(mnew > mrun)) {
#pragma unroll
        for (int d = 0; d < DVB; ++d) o[d] = o[d] * alpha;
    }
    mrun = mnew;
    const bf16x8 p0 = pack8(st[0], st[1], st[2], st[3], st[4], st[5], st[6], st[7]), p1 = pack8(st[8], st[9], st[10], st[11], st[12], st[13], st[14], st[15]);
#pragma unroll
    for (int d = 0; d < DVB; ++d) { o[d] = mfma32(vl(d, 0), p0, o[d]); o[d] = mfma32(vl(d, 1), p1, o[d]); }
}

__device__ __forceinline__ bf16x8 ld_f32x8(const float* p) { return pack8v(*(const f32x4*)p, *(const f32x4*)(p + 4)); }
__device__ __forceinline__ bf16x8 ld_f32_44(const float* p) { return pack8v(*(const f32x4*)p, *(const f32x4*)(p + 8)); }
__device__ __forceinline__ bf16x8 ld_f32_strided(const float* p, int pitch) {
    return pack8(p[0], p[pitch], p[2 * pitch], p[3 * pitch], p[8 * pitch], p[9 * pitch], p[10 * pitch], p[11 * pitch]);
}

template <int DVB, bool GATE>
__device__ __forceinline__ void attn_store(const f32x16 (&o)[DVB], float inv, bf16_t* rowp  , int hi) {
#pragma unroll
    for (int d = 0; d < DVB; ++d)
#pragma unroll
        for (int g4 = 0; g4 < 4; ++g4) { bf16_t* p = rowp + 32 * d + 8 * g4 + 4 * hi; float v0 = o[d][4 * g4] * inv, v1 = o[d][4 * g4 + 1] * inv, v2 = o[d][4 * g4 + 2] * inv, v3 = o[d][4 * g4 + 3] * inv;
            if (GATE) { const u32x2 g = *(const u32x2*)p; v0 *= silu(bflo(g.x)); v1 *= silu(bfhi(g.x)); v2 *= silu(bflo(g.y)); v3 *= silu(bfhi(g.y)); }
            u32x2 w; w.x = pk2(v0, v1); w.y = pk2(v2, v3); *(u32x2*)p = w; }
}

__device__ __forceinline__ void mla_prompt_unit(bf16_t* PJ, const bf16_t* VT, int b, int h, int qb, LAS unsigned char* ldsl, int dry) {
    const int tid = opaque_tid(), lane = tid & 63, wave = __builtin_amdgcn_readfirstlane(tid >> 6), l31 = lane & 31, hi = lane >> 5;
    constexpr int KP = 104, VP = 72, KBUF = 64 * KP * 2, SETB = KBUF + 64 * VP * 2;
    const int q0 = qb * 256 + wave * 32;
    bf16_t* qrow = PJ + (size_t)((size_t)b * SEQ + q0 + l31) * NPJ;
    bf16x8 q[6];
#pragma unroll
    for (int s = 0; s < 6; ++s) q[s] = *(const bf16x8*)(qrow + C_Q + h * 96 + 16 * s + 8 * hi);
    f32x16 o[2];
#pragma unroll
    for (int r = 0; r < 16; ++r) { o[0][r] = 0.f; o[1][r] = 0.f; }
    float mrun = -INFINITY, lrun = 0.f;
    const int ntile = 4 * qb + 4, ntw = (q0 >> 6) + 1;
    const bf16_t* kg = PJ + (size_t)((size_t)b * SEQ + (tid >> 3)) * NPJ + C_KN + h * 64 + (tid & 7) * 8;
    const bf16_t* rg = PJ + (size_t)((size_t)b * SEQ + ((tid & 255) >> 2)) * NPJ + C_KR + (tid & 3) * 8;
    const bf16_t* vg = VT + (size_t)(h * 64 + (tid >> 3)) * MP + (size_t)b * SEQ + (tid & 7) * 8;
    const int kofs = ((tid >> 3) * KP + (tid & 7) * 8) * 2, rofs = (((tid & 255) >> 2) * KP + 64 + (tid & 3) * 8) * 2, vofs = KBUF + ((tid >> 3) * VP + (tid & 7) * 8) * 2;
    u32x4 sk, sr, sv, sk2, sr2, sv2;
    sk = *(const u32x4*)kg; sr = *(const u32x4*)rg; sv = *(const u32x4*)vg;
    *(LAS u32x4*)(ldsl + kofs) = sk; if (tid < 256) *(LAS u32x4*)(ldsl + rofs) = sr; *(LAS u32x4*)(ldsl + vofs) = sv;
    sk = *(const u32x4*)(kg + (size_t)64 * NPJ); sr = *(const u32x4*)(rg + (size_t)64 * NPJ); sv = *(const u32x4*)(vg + 64);
    sk2 = sk; sr2 = sr; sv2 = sv;
    __syncthreads();
    for (int t = 0; t < ntile; ++t) {
        const int buf = (t & 1) * SETB, nbuf = ((t + 1) & 1) * SETB;
        if (t + 2 < ntile) { sk2 = *(const u32x4*)(kg + (size_t)(t + 2) * 64 * NPJ); sr2 = *(const u32x4*)(rg + (size_t)(t + 2) * 64 * NPJ); sv2 = *(const u32x4*)(vg + (t + 2) * 64); }
        if (t < ntw) {
#pragma unroll
            for (int hf = 0; hf < 2; ++hf) {
                const LAS unsigned char* kb = ldsl + buf + ((32 * hf + l31) * KP + 8 * hi) * 2;
                const LAS unsigned char* vb = ldsl + buf + KBUF + (l31 * VP + 32 * hf + 4 * hi) * 2;
                auto kl = [&](int s) -> bf16x8 { return *(const LAS bf16x8*)(kb + 32 * s); };
                auto vl = [&](int d, int j) -> bf16x8 { const LAS unsigned char* vp = vb + (32 * d * VP + 16 * j) * 2; return cat8(*(const LAS u32x2*)vp, *(const LAS u32x2*)(vp + 16)); };
                attn_half<6, 2>(o, mrun, lrun, q, MLA_SC, kl, vl);
            }
        }
        if (t + 1 < ntile) { *(LAS u32x4*)(ldsl + nbuf + kofs) = sk; if (tid < 256) *(LAS u32x4*)(ldsl + nbuf + rofs) = sr; *(LAS u32x4*)(ldsl + nbuf + vofs) = sv; }
        sk = sk2; sr = sr2; sv = sv2;
        __syncthreads();
    }
    const float lt = lrun + __shfl_xor(lrun, 32);
    if (!dry) attn_store<2, true>(o, 1.f / lt, qrow + C_GM + h * 64, hi);
}

__device__ __forceinline__ void mem_attn_unit(bf16_t* PJ, const float* KB, const float* VB, int r0, int nqb, int h, LAS unsigned char* ldsl, int dry) {
    const int tid = opaque_tid(), lane = tid & 63, wave = __builtin_amdgcn_readfirstlane(tid >> 6), l31 = lane & 31, hi = lane >> 5;
    const int qblk = wave & 3, dp = wave >> 2; const bool act = qblk < nqb;
    constexpr int KP = 264, HBY = 32 * KP * 2, SETB = 2 * HBY;
    bf16_t* qrow = PJ + (size_t)(r0 + (act ? qblk : 0) * 32 + l31) * NPJ;
    bf16x8 q[16];
#pragma unroll
    for (int s = 0; s < 16; ++s) q[s] = *(const bf16x8*)(qrow + C_QM + h * 256 + 16 * s + 8 * hi);
    f32x16 o[4];
#pragma unroll
    for (int d = 0; d < 4; ++d)
#pragma unroll
        for (int r = 0; r < 16; ++r) o[d][r] = 0.f;
    float mrun = -INFINITY, lrun = 0.f;
    f32x4 sg[8];
    const float* kg = KB + h * 256; const float* vg = VB + h * 256;
#define MEM_ISSUE(hf) do { _Pragma("unroll") for (int i_ = 0; i_ < 4; ++i_) { const int idx_ = tid + 512 * i_; const size_t o_ = (size_t)((hf) * 32 + (idx_ >> 6)) * 1024 + (idx_ & 63) * 4; sg[i_] = *(const f32x4*)(kg + o_); sg[4 + i_] = *(const f32x4*)(vg + o_); } } while (0)
#define MEM_COMMIT(bufo) do { _Pragma("unroll") for (int i_ = 0; i_ < 4; ++i_) { const int idx_ = tid + 512 * i_; const int lo_ = ((idx_ >> 6) * KP + (idx_ & 63) * 4) * 2; u32x2 w_; \
        w_.x = pk2(sg[i_].x, sg[i_].y); w_.y = pk2(sg[i_].z, sg[i_].w); *(LAS u32x2*)(ldsl + (bufo) + lo_) = w_; \
        w_.x = pk2(sg[4 + i_].x, sg[4 + i_].y); w_.y = pk2(sg[4 + i_].z, sg[4 + i_].w); *(LAS u32x2*)(ldsl + (bufo) + HBY + lo_) = w_; } } while (0)
    MEM_ISSUE(0); MEM_COMMIT(0);
    __syncthreads();
    for (int hf = 0; hf < 8; ++hf) {
        const int buf = (hf & 1) * SETB, nbuf = ((hf + 1) & 1) * SETB;
        if (hf + 1 < 8) MEM_ISSUE(hf + 1);
        if (act) {
            const LAS unsigned char* kb = ldsl + buf + (l31 * KP + 8 * hi) * 2;
            const LAS unsigned short* vb = (const LAS unsigned short*)(ldsl + buf + HBY) + (4 * hi) * KP + dp * 128 + l31;
            auto kl = [&](int s) -> bf16x8 { return *(const LAS bf16x8*)(kb + 32 * s); };
            auto vl = [&](int d, int j) -> bf16x8 { const LAS unsigned short* vp = vb + 16 * j * KP + 32 * d; u32x4 w;
                w.x = (unsigned)vp[0] | ((unsigned)vp[KP] << 16); w.y = (unsigned)vp[2 * KP] | ((unsigned)vp[3 * KP] << 16); w.z = (unsigned)vp[8 * KP] | ((unsigned)vp[9 * KP] << 16); w.w = (unsigned)vp[10 * KP] | ((unsigned)vp[11 * KP] << 16);
                return __builtin_bit_cast(bf16x8, w); };
            attn_half<16, 4>(o, mrun, lrun, q, MEM_SC, kl, vl);
        }
        if (hf + 1 < 8) MEM_COMMIT(nbuf);
        __syncthreads();
    }
#undef MEM_ISSUE
#undef MEM_COMMIT
    const float lt = lrun + __shfl_xor(lrun, 32);
    if (act && !dry) attn_store<4, false>(o, 1.f / lt, qrow + C_QM + h * 256 + dp * 128, hi);
}

__device__ __forceinline__ void mla_sample_unit(const PL& P, bf16_t* PJ, const bf16_t* WUVT, float* PART, int layer, int b, int hgq, int sp, LAS unsigned char* ldsl, int dry) {
    const int tid = opaque_tid(), lane = tid & 63, wave = __builtin_amdgcn_readfirstlane(tid >> 6), l31 = lane & 31, hi = lane >> 5;
    const int h = 4 * hgq + (wave & 3), ch = wave >> 2;
    constexpr int KP = 296, BUFB = 64 * KP * 2;
    bf16_t* qrow = PJ + (size_t)(MP + b * DSEQ + l31) * NPJ;
    bf16x8 q[18];
    {
        bf16x8 qn[4];
#pragma unroll
        for (int s = 0; s < 4; ++s) qn[s] = *(const bf16x8*)(qrow + C_Q + h * 96 + 16 * s + 8 * hi);
        const float* wuk = P.in(22) + (size_t)layer * 256 * 1024 + h * 64 + 8 * hi;
#pragma unroll
        for (int cb = 0; cb < 8; ++cb) { f32x16 a;
#pragma unroll
            for (int r = 0; r < 16; ++r) a[r] = 0.f;
#pragma unroll
            for (int s = 0; s < 4; ++s) a = mfma32(ld_f32x8(wuk + (size_t)(32 * cb + l31) * 1024 + 16 * s), qn[s], a);
            q[2 * cb] = pack8(a[0], a[1], a[2], a[3], a[4], a[5], a[6], a[7]); q[2 * cb + 1] = pack8(a[8], a[9], a[10], a[11], a[12], a[13], a[14], a[15]); }
        q[16] = *(const bf16x8*)(qrow + C_Q + h * 96 + 64 + 8 * hi); q[17] = *(const bf16x8*)(qrow + C_Q + h * 96 + 80 + 8 * hi);
    }
    const float* cckv = P.in(5) + ((size_t)(layer * NSB + b) * PAST + (size_t)sp * 512) * 256; const float* ckr = P.in(6) + ((size_t)(layer * NSB + b) * PAST + (size_t)sp * 512) * 32;
    const float* nckv = P.out() + O_SCKV + (size_t)(layer * NSB + b) * DSEQ * 256; const float* nkr = P.out() + O_SKR + (size_t)(layer * NSB + b) * DSEQ * 32;
    const int nsteps = sp == 7 ? 9 : 8;
    f32x16 oT[2];
#pragma unroll
    for (int r = 0; r < 16; ++r) { oT[0][r] = 0.f; oT[1][r] = 0.f; }
    float lt = 1.f, mfin = 0.f;
    f32x4 sg[9];
#define SMP_ISSUE(st) do { const bool nw_ = (st) == 8; const float* cb_ = nw_ ? nckv : cckv + (size_t)(st) * 64 * 256; const float* rb_ = nw_ ? nkr : ckr + (size_t)(st) * 64 * 32; \
        _Pragma("unroll") for (int i_ = 0; i_ < 8; ++i_) { const int idx_ = tid + 512 * i_; sg[i_] = (nw_ && idx_ >= 32 * 64) ? (f32x4){0.f, 0.f, 0.f, 0.f} : *(const f32x4*)(cb_ + (size_t)idx_ * 4); } \
        sg[8] = (nw_ && tid >= 32 * 8) ? (f32x4){0.f, 0.f, 0.f, 0.f} : *(const f32x4*)(rb_ + (size_t)tid * 4); } while (0)
#define SMP_COMMIT(bufo) do { \
        _Pragma("unroll") for (int i_ = 0; i_ < 8; ++i_) { const int idx_ = tid + 512 * i_; u32x2 w_; w_.x = pk2(sg[i_].x, sg[i_].y); w_.y = pk2(sg[i_].z, sg[i_].w); *(LAS u32x2*)(ldsl + (bufo) + ((idx_ >> 6) * KP + (idx_ & 63) * 4) * 2) = w_; } \
        { u32x2 w_; w_.x = pk2(sg[8].x, sg[8].y); w_.y = pk2(sg[8].z, sg[8].w); *(LAS u32x2*)(ldsl + (bufo) + ((tid >> 3) * KP + 256 + (tid & 7) * 4) * 2) = w_; } } while (0)
    {
        f32x16 o[4];
#pragma unroll
        for (int d = 0; d < 4; ++d)
#pragma unroll
            for (int r = 0; r < 16; ++r) o[d][r] = 0.f;
        float mrun = -INFINITY, lrun = 0.f;
        SMP_ISSUE(0); SMP_COMMIT(0);
        __syncthreads();
        for (int st = 0; st < nsteps; ++st) {
            const int buf = (st & 1) * BUFB, nbuf = ((st + 1) & 1) * BUFB;
            if (st + 1 < nsteps) SMP_ISSUE(st + 1);
            const int nh = st == 8 ? 1 : 2;
            for (int hf = 0; hf < nh; ++hf) {
                const LAS unsigned char* kb = ldsl + buf + ((32 * hf + l31) * KP + 4 * hi) * 2;
                const LAS unsigned short* vb = (const LAS unsigned short*)(ldsl + buf) + (32 * hf + 4 * hi) * KP + ch * 128 + l31;
                auto kl = [&](int s) -> bf16x8 { if (s < 16) { const LAS unsigned char* kp = kb + 32 * s; return cat8(*(const LAS u32x2*)kp, *(const LAS u32x2*)(kp + 16)); } return *(const LAS bf16x8*)(kb + (256 + (s - 16) * 16 + 4 * hi) * 2); };
                auto vl = [&](int d, int j) -> bf16x8 { const LAS unsigned short* vp = vb + 16 * j * KP + 32 * d; u32x4 w;
                    w.x = (unsigned)vp[0] | ((unsigned)vp[KP] << 16); w.y = (unsigned)vp[2 * KP] | ((unsigned)vp[3 * KP] << 16); w.z = (unsigned)vp[8 * KP] | ((unsigned)vp[9 * KP] << 16); w.w = (unsigned)vp[10 * KP] | ((unsigned)vp[11 * KP] << 16);
                    return __builtin_bit_cast(bf16x8, w); };
                attn_half<18, 4>(o, mrun, lrun, q, MLA_SC, kl, vl);
            }
            if (st + 1 < nsteps) SMP_COMMIT(nbuf);
            __syncthreads();
        }
        lt = lrun + __shfl_xor(lrun, 32); mfin = mrun;
#pragma unroll
        for (int d = 0; d < 4; ++d) { const int cb = 4 * ch + d;
            const bf16x8 p0 = pack8(o[d][0], o[d][1], o[d][2], o[d][3], o[d][4], o[d][5], o[d][6], o[d][7]), p1 = pack8(o[d][8], o[d][9], o[d][10], o[d][11], o[d][12], o[d][13], o[d][14], o[d][15]);
#pragma unroll
            for (int db = 0; db < 2; ++db) { const bf16_t* wp = WUVT + (size_t)(h * 64 + 32 * db + l31) * 256 + 32 * cb + 4 * hi;
                oT[db] = mfma32(cat8(*(const u32x2*)wp, *(const u32x2*)(wp + 8)), p0, oT[db]);
                oT[db] = mfma32(cat8(*(const u32x2*)(wp + 16), *(const u32x2*)(wp + 24)), p1, oT[db]); } }
    }
#undef SMP_ISSUE
#undef SMP_COMMIT
    float* pp = PART + ((size_t)(((b * 8 + sp) * 16 + h) * 2 + ch) * 34) * 64 + lane;
    if (!dry) { pp[0] = mfin; pp[64] = lt;
#pragma unroll
    for (int r = 0; r < 16; ++r) { pp[(2 + r) * 64] = oT[0][r]; pp[(18 + r) * 64] = oT[1][r]; } }
}
__device__ __forceinline__ void mla_sample_combine(bf16_t* PJ, const float* PART, int b, int h, int dry) {
    const int lane = opaque_tid() & 63, l31 = lane & 31, hi = lane >> 5;
    float M = -INFINITY;
#pragma unroll 1
    for (int sp = 0; sp < 8; ++sp) M = fmaxf(M, PART[((size_t)(((b * 8 + sp) * 16 + h) * 2) * 34) * 64 + lane]);
    f32x16 oT[2]; float L = 0.f;
#pragma unroll
    for (int r = 0; r < 16; ++r) { oT[0][r] = 0.f; oT[1][r] = 0.f; }
#pragma unroll 1
    for (int sp = 0; sp < 8; ++sp) { const float* pp = PART + ((size_t)(((b * 8 + sp) * 16 + h) * 2) * 34) * 64 + lane; const float f = ex2((pp[0] - M) * MLA_SC); L += f * pp[64];
#pragma unroll
        for (int r = 0; r < 16; ++r) { oT[0][r] += f * (pp[(2 + r) * 64] + pp[(34 + 2 + r) * 64]); oT[1][r] += f * (pp[(18 + r) * 64] + pp[(34 + 18 + r) * 64]); } }
    bf16_t* qrow = PJ + (size_t)(MP + b * DSEQ + l31) * NPJ;
    if (!dry) attn_store<2, true>(oT, 1.f / L, qrow + C_GM + h * 64, hi);
}

__device__ __forceinline__ float wave_incl_scan(float v, int lane) {
#pragma unroll
    for (int o = 1; o < 64; o <<= 1) { const float t = __shfl_up(v, o); if (lane >= o) v += t; }
    return v;
}
__device__ __forceinline__ void ssd_unit(const PL& P, int layer, int sample, int b, int hd, unsigned char* lds, int tid_in, int wave, int lane_in, int dry) {
    const int g = hd >> 3; int tid = tid_in; asm volatile("" : "+v"(tid)); int lane = tid & 63, l31 = lane & 31, hi = lane >> 5;
    const size_t rowbase = sample ? (size_t)(MP + b * DSEQ) : (size_t)b * SEQ;
    const int nchunk = sample ? 1 : 64, nvalid = sample ? 32 : 64;
    bf16_t* PJ = (bf16_t*)(P.ws() + WS_PROJ); const bf16_t* BCC = (const bf16_t*)(P.ws() + WS_XB);
    const float a_h = -__expf(P.in(15)[layer * 32 + hd]), dtb = P.in(14)[layer * 32 + hd], dsk = P.in(16)[layer * 32 + hd];
    constexpr int PW = 136, PN = 72;
    bf16_t* CM = (bf16_t*)lds; bf16_t* BMs = CM + 64 * PW; bf16_t* BT = BMs + 64 * PW; bf16_t* XT = BT + 128 * PN; bf16_t* XS = XT + 64 * PN; bf16_t* HB = XS + 64 * PN;
    float* CWT = (float*)(lds + 90112);
    for (int i = tid; i < 320; i += 512) { const int o_ = i / 40, r_ = i % 40, k_ = r_ >> 3, j_ = r_ & 7;
        const int xc_ = hd * 64 + o_ * 8 + j_;
        CWT[i] = r_ < 32 ? P.in(12)[(size_t)(layer * 4 + k_) * 3072 + xc_] : P.in(13)[(size_t)layer * 3072 + xc_]; }
    const int ph = wave >> 2, nq = wave & 3;
    f32x16 Hacc;
    if (sample) { const float* sp = P.in(3) + ((size_t)(layer * NSB + b) * 32 + hd) * 8192;
#pragma unroll
        for (int r = 0; r < 16; ++r) Hacc[r] = sp[(32 * ph + crow(r, hi)) * 128 + 32 * nq + l31]; }
    else {
#pragma unroll
        for (int r = 0; r < 16; ++r) Hacc[r] = 0.f; }
#pragma unroll
    for (int r = 0; r < 16; ++r) HB[(32 * ph + crow(r, hi)) * PW + 32 * nq + l31] = (bf16_t)f2bf(Hacc[r]);
    __syncthreads();

    u32x4 raw[11]; unsigned short dtr = 0;
#define SSD_LOAD(RAW, DTR, CH) do { int t0_ = (CH) * 64; asm volatile("" : "+s"(t0_)); \
        if (lane < nvalid) DTR = PJ[(rowbase + t0_ + lane) * NPJ + C_DT + hd]; \
        if (tid < 64) { const int oct_ = tid & 7, rg_ = tid >> 3; const int xcol_ = hd * 64 + oct_ * 8; \
            _Pragma("unroll") for (int i = 0; i < 11; ++i) { const int tt = t0_ + rg_ * 8 + i - 3; u32x4 v = (u32x4){0u, 0u, 0u, 0u}; \
                if (tt >= 0) { if (tt < (sample ? DSEQ : SEQ)) v = *(const u32x4*)(PJ + (rowbase + tt) * NPJ + C_XBC + xcol_); } \
                else if (sample) { const float* sp = P.in(4) + ((size_t)(layer * NSB + b) * 3 + (3 + tt)) * 3072 + xcol_; const f32x4 a = *(const f32x4*)sp, c = *(const f32x4*)(sp + 4); \
                    v.x = pk2(a.x, a.y); v.y = pk2(a.z, a.w); v.z = pk2(c.x, c.y); v.w = pk2(c.z, c.w); } \
                RAW[i] = v; } } \
        else if (tid < 320) { const int o2_ = (tid - 64) & 31, rg_ = (tid - 64) >> 5; const int bcc_ = (o2_ < 16 ? g * 128 + o2_ * 8 : 512 + g * 128 + (o2_ - 16) * 8); \
            _Pragma("unroll") for (int i = 3; i < 11; ++i) { const int tt = t0_ + rg_ * 8 + i - 3; \
                RAW[i] = tt < (sample ? DSEQ : SEQ) ? *(const u32x4*)(BCC + (rowbase + tt) * 1024 + bcc_) : (u32x4){0u, 0u, 0u, 0u}; } } } while (0)
    SSD_LOAD(raw, dtr, 0);
    for (int ch = 0; ch < nchunk; ++ch) {
        const int t0 = ch * 64;
        tid = tid_in; asm volatile("" : "+v"(tid)); lane = tid & 63; l31 = lane & 31; hi = lane >> 5;
        const int oct = tid < 64 ? (tid & 7) : 8 + ((tid - 64) & 31), rg = tid < 64 ? (tid >> 3) : ((tid - 64) >> 5);
        const int xcol = hd * 64 + (oct & 7) * 8;
        float dtl = 0.f;
        if (lane < nvalid) { const float rawd = bf2f(dtr) + dtb; dtl = rawd > 20.f ? rawd : log1pf(__expf(rawd)); }
        const float acs = wave_incl_scan(dtl * a_h, lane);
        const float acs63 = __shfl(acs, 63);
        if (tid < 320) {
            if (!dry && ch == nchunk - 1 && rg == (nvalid >> 3) - 1 && tid < 64) {
                float* cp = sample ? P.out() + O_SCONV + (size_t)(layer * NSB + b) * 3 * 3072 + xcol : P.out() + O_PCONV + (size_t)(layer * NB + b) * 3 * 3072 + xcol;
#pragma unroll
                for (int k = 0; k < 3; ++k) { const u32x4 v = raw[8 + k]; *(f32x4*)(cp + (size_t)k * 3072) = (f32x4){bflo(v.x), bfhi(v.x), bflo(v.y), bfhi(v.y)}; *(f32x4*)(cp + (size_t)k * 3072 + 4) = (f32x4){bflo(v.z), bfhi(v.z), bflo(v.w), bfhi(v.w)}; }
            }
            unsigned tp[8][4];
#pragma unroll
            for (int i = 0; i < 8; ++i) {
                const int tt = rg * 8 + i;
                float y[8]; u32x4 w;
                if (tid < 64) {
                    { const f32x4 b0 = *(const f32x4*)(CWT + oct * 40 + 32), b1 = *(const f32x4*)(CWT + oct * 40 + 36); y[0] = b0.x; y[1] = b0.y; y[2] = b0.z; y[3] = b0.w; y[4] = b1.x; y[5] = b1.y; y[6] = b1.z; y[7] = b1.w; }
#pragma unroll
                    for (int k = 0; k < 4; ++k) { const u32x4 v = raw[i + k]; const f32x4 w0 = *(const f32x4*)(CWT + oct * 40 + k * 8), w1 = *(const f32x4*)(CWT + oct * 40 + k * 8 + 4);
                        y[0] += w0.x * bflo(v.x); y[1] += w0.y * bfhi(v.x); y[2] += w0.z * bflo(v.y); y[3] += w0.w * bfhi(v.y);
                        y[4] += w1.x * bflo(v.z); y[5] += w1.y * bfhi(v.z); y[6] += w1.z * bflo(v.w); y[7] += w1.w * bfhi(v.w); }
                    asm volatile("" ::: "memory");
#pragma unroll
                    for (int j = 0; j < 8; ++j) y[j] = silu(y[j]);
                    w.x = pk2(y[0], y[1]); w.y = pk2(y[2], y[3]); w.z = pk2(y[4], y[5]); w.w = pk2(y[6], y[7]);
                } else {
                    w = raw[i + 3]; y[0] = bflo(w.x); y[1] = bfhi(w.x); y[2] = bflo(w.y); y[3] = bfhi(w.y); y[4] = bflo(w.z); y[5] = bfhi(w.z); y[6] = bflo(w.w); y[7] = bfhi(w.w);
                }
                const float dt_t = __shfl(dtl, tt), acs_t = __shfl(acs, tt);
                float sc = 1.f;
                if (oct < 8) { *(u32x4*)(XS + tt * PN + oct * 8) = w; sc = dt_t; }
                else if (oct < 24) { *(u32x4*)(BMs + tt * PW + (oct - 8) * 8) = w; sc = fexp(acs63 - acs_t); }
                else { *(u32x4*)(CM + tt * PW + (oct - 24) * 8) = w; }
#pragma unroll
                for (int j = 0; j < 8; ++j) { const unsigned hv = f2bf(y[j] * sc); if (i & 1) tp[j][i >> 1] |= hv << 16; else tp[j][i >> 1] = hv; }
            }
            if (oct < 8) {
#pragma unroll
                for (int j = 0; j < 8; ++j) *(u32x4*)(XT + (oct * 8 + j) * PN + rg * 8) = (u32x4){tp[j][0], tp[j][1], tp[j][2], tp[j][3]};
            } else if (oct < 24) {
#pragma unroll
                for (int j = 0; j < 8; ++j) *(u32x4*)(BT + ((oct - 8) * 8 + j) * PN + rg * 8) = (u32x4){tp[j][0], tp[j][1], tp[j][2], tp[j][3]};
            }
        }
        if (ch + 1 < nchunk) SSD_LOAD(raw, dtr, ch + 1);
        unsigned short zv[16];
        if (wave < 4 && 32 * (wave >> 1) < nvalid) {
            int t0z = t0; asm volatile("" : "+s"(t0z));
#pragma unroll
            for (int r = 0; r < 16; ++r) { const int l = 32 * (wave >> 1) + crow(r, hi); zv[r] = l < nvalid ? PJ[(rowbase + t0z + l) * NPJ + C_Z + hd * 64 + 32 * (wave & 1) + l31] : (unsigned short)0; }
        }
        __syncthreads();
        {
            const float dec = fexp(acs63);
#pragma unroll
            for (int r = 0; r < 16; ++r) Hacc[r] *= dec;
        }
        f32x16 Hn = Hacc;
#pragma unroll
        for (int ks = 0; ks < 4; ++ks) Hn = mfma32(*(const bf16x8*)(XT + (32 * ph + l31) * PN + 16 * ks + 8 * hi), *(const bf16x8*)(BT + (32 * nq + l31) * PN + 16 * ks + 8 * hi), Hn);
        Hacc = Hn;
        if (wave < 4) {
            const int lb = wave >> 1, pb = wave & 1;
            if (32 * lb < nvalid) {
                const int lme = 32 * lb + l31; const float acs_l = __shfl(acs, lme);
                f32x16 ya;
#pragma unroll
                for (int r = 0; r < 16; ++r) ya[r] = 0.f;
#pragma unroll
                for (int k = 0; k < 8; ++k) ya = mfma32(*(const bf16x8*)(CM + (32 * lb + l31) * PW + 16 * k + 8 * hi), *(const bf16x8*)(HB + (32 * pb + l31) * PW + 16 * k + 8 * hi), ya);
#pragma unroll
                for (int r = 0; r < 16; ++r) ya[r] *= fexp(__shfl(acs, 32 * lb + crow(r, hi)));
                for (int hs = 0; hs <= lb; ++hs) {
                    f32x16 st;
#pragma unroll
                    for (int r = 0; r < 16; ++r) st[r] = 0.f;
#pragma unroll
                    for (int k = 0; k < 8; ++k) st = mfma32(*(const bf16x8*)(BMs + (32 * hs + l31) * PW + 16 * k + 8 * hi), *(const bf16x8*)(CM + (32 * lb + l31) * PW + 16 * k + 8 * hi), st);
#pragma unroll
                    for (int r = 0; r < 16; ++r) { const int s = 32 * hs + crow(r, hi); const float as = __shfl(acs, s); st[r] = (s <= lme) ? st[r] * fexp(acs_l - as) : 0.f; }
                    const bf16x8 m0 = pack8(st[0], st[1], st[2], st[3], st[4], st[5], st[6], st[7]), m1 = pack8(st[8], st[9], st[10], st[11], st[12], st[13], st[14], st[15]);
                    const bf16_t* xp = XT + (32 * pb + l31) * PN + 32 * hs + 4 * hi;
                    ya = mfma32(m0, cat8(*(const u32x2*)xp, *(const u32x2*)(xp + 8)), ya);
                    ya = mfma32(m1, cat8(*(const u32x2*)(xp + 16), *(const u32x2*)(xp + 24)), ya);
                }
#pragma unroll
                for (int r = 0; r < 16; ++r) { const int l = 32 * lb + crow(r, hi);
                    if (l < nvalid) { bf16_t* zp = PJ + (rowbase + t0 + l) * NPJ + C_Z + hd * 64 + 32 * pb + l31;
                        const float y = ya[r] + dsk * bf2f(XS[l * PN + 32 * pb + l31]); const unsigned zz = f2bf(y * silu(bf2f(zv[r]))); if (!dry) *zp = (bf16_t)zz; } }
            }
        }
        __syncthreads();
#pragma unroll
        for (int r = 0; r < 16; ++r) HB[(32 * ph + crow(r, hi)) * PW + 32 * nq + l31] = (bf16_t)f2bf(Hacc[r]);
    }
#undef SSD_LOAD
    float* so = sample ? P.out() + O_SSSM + ((size_t)(layer * NSB + b) * 32 + hd) * 8192 : P.out() + O_PSSM + ((size_t)(layer * NB + b) * 32 + hd) * 8192;
    if (!dry) {
#pragma unroll
    for (int r = 0; r < 16; ++r) so[(32 * ph + crow(r, hi)) * 128 + 32 * nq + l31] = Hacc[r]; }
    __syncthreads();
}

__device__ __forceinline__ void set_job(pg8::Job* j, const bf16_t* A, int lda, const bf16_t* Bt, int ldb, int K, int nM, int nN, void* O, int ldc, int epi, const void* aux, const void* aux2, int auxi) {
    j->A = A; j->Bt = Bt; j->O = O; j->aux = aux; j->aux2 = aux2; j->lda = lda; j->ldb = ldb; j->K = K; j->nM = nM; j->nN = nN; j->ldc = ldc; j->epi = epi; j->auxi = auxi;
}
constexpr int JOB_WORDS = sizeof(pg8::Job) / 4, JT_PHASE_WORDS = 9 * JOB_WORDS;
__device__ __forceinline__ void load_jobs(LAS pg8::Job* jt, const unsigned* gt, int tid) {
    if (tid < JT_PHASE_WORDS) ((LAS unsigned*)jt)[tid] = gt[tid];
    __syncthreads();
}

__global__ void __launch_bounds__(512, 2) mega(Params KP) {
    extern __shared__ __attribute__((aligned(16))) unsigned char lds[];
    if (threadIdx.x == 0) { volatile LAS unsigned long long* pd = (volatile LAS unsigned long long*)((LAS unsigned char*)lds + PARAM_OFF);
#pragma unroll
        for (int i = 0; i < 31; ++i) pd[i] = (unsigned long long)KP.in[i];
        pd[31] = (unsigned long long)KP.out; pd[32] = (unsigned long long)KP.ws; }
    __syncthreads();
    PL P; P.base = (const volatile LAS unsigned*)((LAS unsigned char*)lds + PARAM_OFF);
    cg::grid_group grid = cg::this_grid();
    const int tid = threadIdx.x, lane = tid & 63, wave = __builtin_amdgcn_readfirstlane(tid >> 6);
    const int G = gridDim.x, c = blockIdx.x, gw = c * 8 + wave, NGW = G * 8;
    LAS unsigned char* ldsl = (LAS unsigned char*)lds;
    LAS pg8::Job* jt = (LAS pg8::Job*)(ldsl + JT_OFF);
    unsigned char* ws = P.ws();
    bf16_t* PJ = (bf16_t*)(ws + WS_PROJ); bf16_t* XB = (bf16_t*)(ws + WS_XB); bf16_t* VT = XB; bf16_t* WB = (bf16_t*)(ws + WS_W); bf16_t* MPB = (bf16_t*)(ws + WS_MPB);
    float* TAB = (float*)(ws + WS_TAB); float* RSTDQ = (float*)(ws + WS_RSTDQ);
    float* X = P.out() + O_Y;

    for (int rep0 = 0; rep0 < (PROBE == 11 ? 2 : 1); ++rep0)
    if constexpr ((PH & 1) != 0) {
        LAS float* scr = (LAS float*)(ldsl + wave * 16384);
        constexpr int I_IN = 16 * (NPJ / 32), I_OSSM = 32 * 32, I_QB = 8 * 48, I_UK = 4 * 32, I_SQ = 16 * 32;
        constexpr int I_LAYER = I_IN + I_OSSM + I_QB + 2 * I_UK + 5 * I_SQ;
        for (int it = gw; it < I_LAYER * DEPTH; it += NGW) {
            const int layer = it / I_LAYER; int r = it % I_LAYER; bf16_t* wl = WB + (size_t)layer * W_LAYER;
            if (r < I_IN) { const int nb = r % (NPJ / 32), kb = r / (NPJ / 32); transpose_item(P.in(11) + (size_t)layer * 1024 * 11072, 1024, 11072, wl + W_IN, kb, win_src(nb * 32), nb * 32, nullptr, scr, lane); continue; } r -= I_IN;
            if (r < I_OSSM) { transpose_item(P.in(18) + (size_t)layer * 2048 * 1024, 2048, 1024, wl + W_OSSM, r / 32, (r % 32) * 32, (r % 32) * 32, P.in(17) + layer * 2048, scr, lane); continue; } r -= I_OSSM;
            if (r < I_QB) { transpose_item(P.in(20) + (size_t)layer * 512 * 1536, 512, 1536, wl + W_QB, r / 48, (r % 48) * 32, (r % 48) * 32, P.in(19) + layer * 512, scr, lane); continue; } r -= I_QB;
            if (r < I_UK) { transpose_item(P.in(22) + (size_t)layer * 256 * 1024, 256, 1024, wl + W_UK, r / 32, (r % 32) * 32, (r % 32) * 32, nullptr, scr, lane); continue; } r -= I_UK;
            if (r < I_UK) { transpose_item(P.in(23) + (size_t)layer * 256 * 1024, 256, 1024, wl + W_UV, r / 32, (r % 32) * 32, (r % 32) * 32, nullptr, scr, lane); continue; } r -= I_UK;
            const int which = r / I_SQ; r %= I_SQ;
            const float* src = which == 0 ? P.in(24) : which == 1 ? P.in(27) : which == 2 ? P.in(28) : which == 3 ? P.in(25) : P.in(26);
            const size_t dst = which == 0 ? W_OMLA : which == 1 ? W_OMEM : which == 2 ? W_OUT : which == 3 ? W_MK : W_MV;
            transpose_item(src + (size_t)layer * 1024 * 1024, 1024, 1024, wl + dst, r / 32, (r % 32) * 32, (r % 32) * 32, nullptr, scr, lane);
        }
        for (int m = gw; m < MT; m += NGW) { const float* src = m < MP ? P.in(0) + (size_t)m * DM : P.in(1) + (size_t)(m - MP) * DM; ln_row(src, P.in(9), P.in(10), X + (size_t)m * DM, XB + (size_t)m * DM, lane); }
        for (int i = c * 512 + tid; i < 2048 * 1024 / 4; i += G * 512) { const f32x4 v = ((const f32x4*)P.in(2))[i]; u32x2 w; w.x = pk2(v.x, v.y); w.y = pk2(v.z, v.w); ((u32x2*)MPB)[i] = w; }
        if (c == 0 && tid == 0) {
            float* out_ = P.out();
            for (int ly = 0; ly < DEPTH; ++ly) {
                pg8::Job* t = (pg8::Job*)(ws + WS_JT) + (size_t)ly * 36; bf16_t* wl_ = WB + (size_t)ly * W_LAYER; int nj = 0;
                if (ly == 0) for (int i = 0; i < DEPTH; ++i) {
                    set_job(t + nj++, MPB, 1024, WB + (size_t)i * W_LAYER + W_MK, 1024, 1024, 8, 4, out_ + O_PMK + (size_t)i * 2048 * 1024, 1024, pg8::E_F32, nullptr, nullptr, 0);
                    set_job(t + nj++, MPB, 1024, WB + (size_t)i * W_LAYER + W_MV, 1024, 1024, 8, 4, out_ + O_PMV + (size_t)i * 2048 * 1024, 1024, pg8::E_F32, nullptr, nullptr, 0); }
                set_job(t + nj++, XB, 1024, wl_ + W_IN, 1024, 1024, MT / 256, NPJ / 256, PJ, NPJ, pg8::E_BF16, nullptr, nullptr, 0);
                t += 9;
                set_job(t + 0, PJ + C_QA, NPJ, wl_ + W_QB, 512, 512, MT / 256, 6, PJ + C_Q, NPJ, pg8::E_QROPE, RSTDQ, TAB, 0);
                set_job(t + 1, PJ + C_KVA, NPJ, wl_ + W_UK, 256, 256, MP / 256, 4, PJ + C_KN, NPJ, pg8::E_BF16, nullptr, nullptr, 0);
                set_job(t + 2, wl_ + W_UV, 256, PJ + C_KVA, NPJ, 256, 4, MP / 256, VT, MP, pg8::E_BF16, nullptr, nullptr, 0);
                t += 9;
                set_job(t + 0, PJ + C_Z, NPJ, wl_ + W_OSSM, 2048, 2048, MT / 256, 4, PJ + C_H, NPJ, pg8::E_MERGE, PJ + C_GT, nullptr, 0);
                set_job(t + 1, PJ + C_GM, NPJ, wl_ + W_OMLA, 1024, 1024, MT / 256, 4, PJ + C_H, NPJ, pg8::E_MERGE, PJ + C_GT + 1024, nullptr, 1);
                set_job(t + 2, PJ + C_QM, NPJ, wl_ + W_OMEM, 1024, 1024, MT / 256, 4, PJ + C_H, NPJ, pg8::E_MERGE, PJ + C_GT + 2048, nullptr, 2);
                t += 9;
                set_job(t + 0, PJ + C_H, NPJ, wl_ + W_OUT, 1024, 1024, MT / 256, 4, out_ + O_Y, 1024, pg8::E_OUT, nullptr, nullptr, 0);
            }
        }
        for (int i = c * 512 + tid; i < 4128 * 16; i += G * 512) { const int pos = i >> 4, k = i & 15; const float inv = powf(10000.0f, -(float)k / 16.0f); const float ang = (float)pos * inv;
            TAB[2 * i] = cosf(ang); TAB[2 * i + 1] = sinf(ang); }
    }
    grid.sync();

#define OPQ_S(x) asm volatile("" : "+s"(x))
#define OPQ_V(x) asm volatile("" : "+v"(x))
    for (int layer = 0; layer < DEPTH; ++layer) {
        unsigned char* wsl = P.ws(); OPQ_S(wsl);
        bf16_t* PJ = (bf16_t*)(wsl + WS_PROJ); bf16_t* XB = (bf16_t*)(wsl + WS_XB); bf16_t* VT = XB; bf16_t* WB = (bf16_t*)(wsl + WS_W); bf16_t* MPB = (bf16_t*)(wsl + WS_MPB);
        float* TAB = (float*)(wsl + WS_TAB); float* RSTDQ = (float*)(wsl + WS_RSTDQ);
        float* X = P.out() + O_Y;
        bf16_t* wl = WB + (size_t)layer * W_LAYER;
        if constexpr ((PH & 2) != 0) {
            const int tid = opaque_tid(), lane = tid & 63; (void)lane;
            load_jobs(jt, (const unsigned*)(wsl + WS_JT) + (size_t)(layer * 4 + 0) * JT_PHASE_WORDS, tid);
            pg8::Sched S{jt, layer == 0 ? 9 : 1, 1, G, c};
            for (int rep = 0; rep < (PROBE == 1 ? 2 : 1); ++rep) pg8::gemm_phase(ldsl, jt, S, rep);
        }
        grid.sync();
        if constexpr ((PH & 4) != 0) {
            const int tid = opaque_tid();
            bf16_t* BCC = XB;
            for (int it = c * 512 + tid; it < (MT / 32) * 128; it += G * 512) {
                const int oct = it & 127, rb = it >> 7, row0 = rb * 32, xcol = 2048 + oct * 8;
                const int samp = row0 >= MP, bb = samp ? (row0 - MP) >> 5 : row0 >> 12, ts = samp ? 0 : (row0 & (SEQ - 1));
                float cw[4][8], cb[8];
#pragma unroll
                for (int k = 0; k < 4; ++k) { const float* wp = P.in(12) + (size_t)(layer * 4 + k) * 3072 + xcol; const f32x4 a = *(const f32x4*)wp, d = *(const f32x4*)(wp + 4);
                    cw[k][0] = a.x; cw[k][1] = a.y; cw[k][2] = a.z; cw[k][3] = a.w; cw[k][4] = d.x; cw[k][5] = d.y; cw[k][6] = d.z; cw[k][7] = d.w; }
                { const float* bp = P.in(13) + (size_t)layer * 3072 + xcol; const f32x4 a = *(const f32x4*)bp, d = *(const f32x4*)(bp + 4);
                  cb[0] = a.x; cb[1] = a.y; cb[2] = a.z; cb[3] = a.w; cb[4] = d.x; cb[5] = d.y; cb[6] = d.z; cb[7] = d.w; }
                const bf16_t* src = PJ + (size_t)row0 * NPJ + C_XBC + xcol;
                u32x4 r0 = (u32x4){0u, 0u, 0u, 0u}, r1 = r0, r2 = r0;
                if (ts > 0) { r0 = *(const u32x4*)(src - 3 * (size_t)NPJ); r1 = *(const u32x4*)(src - 2 * (size_t)NPJ); r2 = *(const u32x4*)(src - (size_t)NPJ); }
                else if (samp) { const float* sp = P.in(4) + (size_t)(layer * NSB + bb) * 3 * 3072 + xcol;
                    { const f32x4 a = *(const f32x4*)sp, d = *(const f32x4*)(sp + 4); r0.x = pk2(a.x, a.y); r0.y = pk2(a.z, a.w); r0.z = pk2(d.x, d.y); r0.w = pk2(d.z, d.w); }
                    { const f32x4 a = *(const f32x4*)(sp + 3072), d = *(const f32x4*)(sp + 3072 + 4); r1.x = pk2(a.x, a.y); r1.y = pk2(a.z, a.w); r1.z = pk2(d.x, d.y); r1.w = pk2(d.z, d.w); }
                    { const f32x4 a = *(const f32x4*)(sp + 6144), d = *(const f32x4*)(sp + 6144 + 4); r2.x = pk2(a.x, a.y); r2.y = pk2(a.z, a.w); r2.z = pk2(d.x, d.y); r2.w = pk2(d.z, d.w); } }
                bf16_t* dst = BCC + (size_t)row0 * 1024 + oct * 8;
#pragma unroll 8
                for (int i = 0; i < 32; ++i) {
                    const u32x4 r3 = *(const u32x4*)(src + (size_t)i * NPJ);
                    float y[8];
#pragma unroll
                    for (int j = 0; j < 8; ++j) y[j] = cb[j];
#define CONV_TAP(k, v) do { y[0] += cw[k][0] * bflo(v.x); y[1] += cw[k][1] * bfhi(v.x); y[2] += cw[k][2] * bflo(v.y); y[3] += cw[k][3] * bfhi(v.y); y[4] += cw[k][4] * bflo(v.z); y[5] += cw[k][5] * bfhi(v.z); y[6] += cw[k][6] * bflo(v.w); y[7] += cw[k][7] * bfhi(v.w); } while (0)
                    CONV_TAP(0, r0); CONV_TAP(1, r1); CONV_TAP(2, r2); CONV_TAP(3, r3);
#undef CONV_TAP
                    u32x4 w; w.x = pk2(silu(y[0]), silu(y[1])); w.y = pk2(silu(y[2]), silu(y[3])); w.z = pk2(silu(y[4]), silu(y[5])); w.w = pk2(silu(y[6]), silu(y[7]));
                    *(u32x4*)(dst + (size_t)i * 1024) = w;
                    r0 = r1; r1 = r2; r2 = r3;
                }
                if (samp || ts == SEQ - 32) {
                    float* cp = samp ? P.out() + O_SCONV + (size_t)(layer * NSB + bb) * 3 * 3072 + xcol : P.out() + O_PCONV + (size_t)(layer * NB + bb) * 3 * 3072 + xcol;
                    *(f32x4*)cp = (f32x4){bflo(r0.x), bfhi(r0.x), bflo(r0.y), bfhi(r0.y)}; *(f32x4*)(cp + 4) = (f32x4){bflo(r0.z), bfhi(r0.z), bflo(r0.w), bfhi(r0.w)};
                    *(f32x4*)(cp + 3072) = (f32x4){bflo(r1.x), bfhi(r1.x), bflo(r1.y), bfhi(r1.y)}; *(f32x4*)(cp + 3072 + 4) = (f32x4){bflo(r1.z), bfhi(r1.z), bflo(r1.w), bfhi(r1.w)};
                    *(f32x4*)(cp + 6144) = (f32x4){bflo(r2.x), bfhi(r2.x), bflo(r2.y), bfhi(r2.y)}; *(f32x4*)(cp + 6144 + 4) = (f32x4){bflo(r2.z), bfhi(r2.z), bflo(r2.w), bfhi(r2.w)};
                }
            }
        }
        grid.sync();
        if constexpr ((PH & 4) != 0) {
            const int tid = opaque_tid(), lane = tid & 63; (void)lane;
            for (int rep = 0; rep < (PROBE == 2 ? 2 : 1); ++rep) { const int dry = rep;
            for (int u = c; u < 256 + 512; u += G) { const int smp = u >= 256, uu = smp ? u - 256 : u; ssd_unit(P, layer, smp, uu >> 5, uu & 31, lds, tid, wave, lane, dry); }
            if (rep == 1) continue;
            for (int m = gw; m < MT; m += NGW) {
                bf16_t* row = PJ + (size_t)m * NPJ;
                const int samp = m >= MP; const int bb = samp ? (m - MP) >> 5 : m >> 12, tt = samp ? (m - MP) & 31 : m & 4095, pos = samp ? PAST + tt : tt;
                { const u32x4 v = *(const u32x4*)(row + C_QA + lane * 8); float s = bflo(v.x) * bflo(v.x) + bfhi(v.x) * bfhi(v.x) + bflo(v.y) * bflo(v.y) + bfhi(v.y) * bfhi(v.y) + bflo(v.z) * bflo(v.z) + bfhi(v.z) * bfhi(v.z) + bflo(v.w) * bflo(v.w) + bfhi(v.w) * bfhi(v.w);
                  s = wave_sum(s); if (lane == 0) RSTDQ[m] = 1.f / sqrtf(s * (1.f / 512.f) + LN_EPS); }
                { const u32x2 v = *(const u32x2*)(row + C_KVA + lane * 4); float a0 = bflo(v.x), a1 = bfhi(v.x), a2 = bflo(v.y), a3 = bfhi(v.y);
                  const float rs = 1.f / sqrtf(wave_sum(a0 * a0 + a1 * a1 + a2 * a2 + a3 * a3) * (1.f / 256.f) + LN_EPS); const f32x4 w = *(const f32x4*)(P.in(21) + layer * 256 + lane * 4);
                  a0 *= rs * w.x; a1 *= rs * w.y; a2 *= rs * w.z; a3 *= rs * w.w;
                  float* op = samp ? P.out() + O_SCKV + ((size_t)(layer * NSB + bb) * DSEQ + tt) * 256 : P.out() + O_PCKV + ((size_t)(layer * NB + bb) * SEQ + tt) * 256;
                  *(f32x4*)(op + lane * 4) = (f32x4){a0, a1, a2, a3}; u32x2 o; o.x = pk2(a0, a1); o.y = pk2(a2, a3); *(u32x2*)(row + C_KVA + lane * 4) = o; }
                { const float x = lane < 32 ? bf2f(row[C_KR + lane]) : 0.f; const float pr = __shfl_xor(x, 16); const int k = lane & 15; const float cs = TAB[((size_t)pos * 16 + k) * 2], sn = TAB[((size_t)pos * 16 + k) * 2 + 1];
                  const float o = (lane & 16) ? x * cs + pr * sn : x * cs - pr * sn;
                  if (lane < 32) { float* op = samp ? P.out() + O_SKR + ((size_t)(layer * NSB + bb) * DSEQ + tt) * 32 : P.out() + O_PKR + ((size_t)(layer * NB + bb) * SEQ + tt) * 32; op[lane] = o; row[C_KR + lane] = (bf16_t)f2bf(o); } }
            }
            }
        }
        grid.sync();
        if constexpr ((PH & 8) != 0) {
            const int tid = opaque_tid(), lane = tid & 63; (void)lane;
            for (int rep = 0; rep < (PROBE == 3 ? 2 : 1); ++rep) { const int dry = rep;
            for (int m = gw; m < MT; m += NGW) {
                bf16_t* row = PJ + (size_t)m * NPJ + C_Z + lane * 32; u32x4 v[4]; float s = 0.f;
#pragma unroll
                for (int j = 0; j < 4; ++j) { v[j] = *(const u32x4*)(row + 8 * j); s += bflo(v[j].x) * bflo(v[j].x) + bfhi(v[j].x) * bfhi(v[j].x) + bflo(v[j].y) * bflo(v[j].y) + bfhi(v[j].y) * bfhi(v[j].y) + bflo(v[j].z) * bflo(v[j].z) + bfhi(v[j].z) * bfhi(v[j].z) + bflo(v[j].w) * bflo(v[j].w) + bfhi(v[j].w) * bfhi(v[j].w); }
                s += __shfl_xor(s, 1); s += __shfl_xor(s, 2); s += __shfl_xor(s, 4); s += __shfl_xor(s, 8);
                const float rs = 1.f / sqrtf(s * (1.f / 512.f) + LN_EPS);
#pragma unroll
                for (int j = 0; j < 4; ++j) { u32x4 o; o.x = pk2(bflo(v[j].x) * rs, bfhi(v[j].x) * rs); o.y = pk2(bflo(v[j].y) * rs, bfhi(v[j].y) * rs); o.z = pk2(bflo(v[j].z) * rs, bfhi(v[j].z) * rs); o.w = pk2(bflo(v[j].w) * rs, bfhi(v[j].w) * rs); if (!dry) *(u32x4*)(row + 8 * j) = o; }
            }
            load_jobs(jt, (const unsigned*)(wsl + WS_JT) + (size_t)(layer * 4 + 1) * JT_PHASE_WORDS, tid);
            pg8::Sched S{jt, 3, 1, G, c};
            pg8::gemm_phase(ldsl, jt, S, dry);
            }
        }
        grid.sync();
        if constexpr ((PH & 16) != 0) {
            const int tid = opaque_tid(), lane = tid & 63; (void)lane; (void)tid;
            float* PART = (float*)(wsl + WS_PART);
            for (int rep = 0; rep < (PROBE == 4 || PROBE == 8 || PROBE == 9 ? 2 : 1); ++rep) { const int dry = rep;
            if (!(dry && PROBE != 4 && PROBE != 8)) for (int u = c; u < 512; u += G) mla_sample_unit(P, PJ, wl + W_UV, PART, layer, u >> 5, (u >> 3) & 3, u & 7, ldsl, dry);
            for (int pi = c; pi < 1024; pi += G) { const int bh = pi >> 3, s = pi & 7;
                for (int k = 0; k < 2; ++k) { const int qb = k ? 15 - s : s; mla_prompt_unit(PJ, VT, bh >> 4, bh & 15, qb, ldsl, dry); } }
            if (dry && PROBE == 8) continue;
            for (int u = c; u < 1024 + 64; u += G) { const int h = u & 3; int r0, nqb; const float* KB; const float* VB;
                if (u < 1024) { r0 = (u >> 2) * 128; nqb = 4; const int bb = r0 >> 12; KB = P.out() + O_PMK + ((size_t)layer * NB + bb) * 256 * 1024; VB = P.out() + O_PMV + ((size_t)layer * NB + bb) * 256 * 1024; }
                else { const int bb = (u - 1024) >> 2; r0 = MP + bb * DSEQ; nqb = 1; KB = P.in(7) + ((size_t)layer * NSB + bb) * 256 * 1024; VB = P.in(8) + ((size_t)layer * NSB + bb) * 256 * 1024; }
                mem_attn_unit(PJ, KB, VB, r0, nqb, h, ldsl, dry); }
            }
        }
        grid.sync();
        if constexpr ((PH & 16) != 0) {
            const int tid = opaque_tid(), lane = tid & 63; (void)lane; (void)tid;
            const float* PART = (const float*)(wsl + WS_PART);
            for (int u = gw; u < 256; u += NGW) mla_sample_combine(PJ, PART, u >> 4, u & 15, 0);
        }
        grid.sync();
        if constexpr ((PH & 32) != 0) {
            const int tid = opaque_tid(), lane = tid & 63; (void)lane;
            load_jobs(jt, (const unsigned*)(wsl + WS_JT) + (size_t)(layer * 4 + 2) * JT_PHASE_WORDS, tid);
            pg8::Sched S{jt, 3, 3, G, c};
            for (int rep = 0; rep < (PROBE == 5 ? 2 : 1); ++rep) pg8::gemm_phase(ldsl, jt, S, rep);
        }
        grid.sync();
        if constexpr ((PH & 64) != 0) {
            const int tid = opaque_tid(), lane = tid & 63; (void)lane;
            load_jobs(jt, (const unsigned*)(wsl + WS_JT) + (size_t)(layer * 4 + 3) * JT_PHASE_WORDS, tid);
            pg8::Sched S{jt, 1, 1, G, c};
            for (int rep = 0; rep < (PROBE == 6 ? 2 : 1); ++rep) pg8::gemm_phase(ldsl, jt, S, rep);
        }
        grid.sync();
        for (int rep = 0; rep < (PROBE == 7 ? 2 : 1); ++rep) { const int lane = opaque_tid() & 63; for (int m = gw; m < MT; m += NGW) ln_row(X + (size_t)m * DM, P.in(29) + layer * DM, P.in(30) + layer * DM, X + (size_t)m * DM, XB + (size_t)m * DM, lane, rep); }
        if (PROBE == 10) for (int k = 0; k < 8; ++k) grid.sync();
        if (layer + 1 < DEPTH) grid.sync();
    }
}

extern "C" void kernel_launch(void* const* d_in, const int* in_sizes, int n_in, void* d_out, int out_size, void* d_ws, size_t ws_size, hipStream_t stream) {
    static int grid = 0;
    if (grid == 0) {
        int dev = 0, cus = 0, per_cu = 0;
        (void)hipGetDevice(&dev);
        (void)hipDeviceGetAttribute(&cus, hipDeviceAttributeMultiprocessorCount, dev);
        (void)hipFuncSetAttribute((const void*)mega, hipFuncAttributeMaxDynamicSharedMemorySize, LDS_BYTES);
        (void)hipOccupancyMaxActiveBlocksPerMultiprocessor(&per_cu, (const void*)mega, 512, LDS_BYTES);
        if (per_cu < 1) per_cu = 1;
        grid = cus * per_cu;
        if (grid % 8) grid -= grid % 8;
        fprintf(stderr, "grid %d (cus %d per_cu %d) ws %zu need %zu\n", grid, cus, per_cu, ws_size, (size_t)WS_END);
        if (ws_size < WS_END || n_in != 31) { fprintf(stderr, "workspace too small or bad inputs\n"); grid = -1; }
    }
    if (grid < 0) return;
    Params p{};
    for (int i = 0; i < 31; ++i) p.in[i] = (const float*)d_in[i];
    p.out = (float*)d_out; p.ws = (unsigned char*)d_ws;
    void* args[] = {&p};
    hipError_t e = hipLaunchCooperativeKernel((const void*)mega, dim3(grid), dim3(512), args, LDS_BYTES, stream);
    if (e != hipSuccess) fprintf(stderr, "coop launch failed: %s\n", hipGetErrorString(e));
}
```
